# Optimizing an MI355X kernel written in HIP

```python
import math
import jax, jax.numpy as jnp
from jax import lax
import numpy as np

D_MODEL = 1024
BATCH = 16
SEQ = 256
DEPTH = 1
DEC_BATCH = 4
DEC_SEQ = 4096
PAST_LEN = 512

GRID_W = 64
N_ATT_HEADS = 8
DIFF_HEAD_DIM = 64
V_HEAD_DIM = 2 * DIFF_HEAD_DIM
QK_WIDTH = N_ATT_HEADS * 2 * DIFF_HEAD_DIM
D_ATT = N_ATT_HEADS * V_HEAD_DIM
D_LRU = 1024
N_LRU_BLOCKS = 8
LRU_BLOCK = D_LRU // N_LRU_BLOCKS
CONV_WIDTH = 4
LRU_C = 8.0
D_MIX = D_ATT + D_LRU
SPLITS = (QK_WIDTH, 2 * QK_WIDTH, 2 * QK_WIDTH + D_ATT, 2 * QK_WIDTH + 2 * D_ATT, 2 * QK_WIDTH + 2 * D_ATT + D_LRU)
D_IN_TOTAL = 2 * QK_WIDTH + 2 * D_ATT + 2 * D_LRU
ROPE_BASE = 10000.0
Q_BLOCK = 128
EPS = 1e-6

kernel_name = "hybrid_diffattn_rglru_prefix_step"


def rms_norm(x, g):
    xf = x.astype(jnp.float32)
    y = xf * lax.rsqrt(jnp.mean(xf * xf, axis=-1, keepdims=True) + EPS)
    return (y * g.astype(jnp.float32)).astype(x.dtype)


def modulation(cond, w_ada, b_ada):
    m = jax.nn.silu(cond) @ w_ada + b_ada
    shift, scale, gate = jnp.split(m, 3, axis=-1)
    return shift, scale, gate


def axial_rope(t):
    T = t.shape[1]
    rows = T // GRID_W
    row = jnp.repeat(jnp.arange(rows, dtype=jnp.float32), GRID_W)
    col = jnp.tile(jnp.arange(GRID_W, dtype=jnp.float32), rows)
    half = DIFF_HEAD_DIM // 2
    nf = half // 2
    inv = ROPE_BASE ** (-jnp.arange(nf, dtype=jnp.float32) * 2.0 / half)

    def rot(x, pos):
        ang = pos[:, None] * inv[None, :]
        cos = jnp.cos(ang)[None, :, None, None, :]
        sin = jnp.sin(ang)[None, :, None, None, :]
        xf = x.astype(jnp.float32)
        x1, x2 = xf[..., :nf], xf[..., nf:]
        return jnp.concatenate([x1 * cos - x2 * sin, x1 * sin + x2 * cos], axis=-1).astype(x.dtype)

    return jnp.concatenate([rot(t[..., :half], row), rot(t[..., half:], col)], axis=-1)


def diff_attention(q, k, v, lam):
    B, S, H, _, d = q.shape
    nb = S // Q_BLOCK
    scale = 1.0 / math.sqrt(d)
    qb = q.reshape(B, nb, Q_BLOCK, H, 2, d).transpose(1, 0, 2, 3, 4, 5)

    def one_block(qblk):
        s = jnp.einsum('bqhmd,bkhmd->bhmqk', qblk, k).astype(jnp.float32) * scale
        p = jax.nn.softmax(s, axis=-1)
        a = p[:, :, 0] - lam * p[:, :, 1]
        return jnp.einsum('bhqk,bkhe->bqhe', a.astype(v.dtype), v)

    o = lax.map(one_block, qb)
    return o.transpose(1, 0, 2, 3, 4).reshape(B, S, H, v.shape[-1])


def centred_conv(x, w, b):
    T = x.shape[1]
    left = (CONV_WIDTH - 1) // 2
    right = CONV_WIDTH - 1 - left
    xp = jnp.pad(x, ((0, 0), (left, right), (0, 0)))
    y = b
    for j in range(CONV_WIDTH):
        y = y + xp[:, j:j + T] * w[j]
    return y


def lru_coeffs(x, w_r, b_r, w_i, b_i, lam):
    B, T, D = x.shape
    xr = x.reshape(B, T, N_LRU_BLOCKS, LRU_BLOCK)
    r = jax.nn.sigmoid(jnp.einsum('btnc,ncd->btnd', xr, w_r).reshape(B, T, D) + b_r)
    i = jax.nn.sigmoid(jnp.einsum('btnc,ncd->btnd', xr, w_i).reshape(B, T, D) + b_i)
    log_a = -LRU_C * r.astype(jnp.float32) * jax.nn.softplus(-lam.astype(jnp.float32))
    a = jnp.exp(log_a)
    mult = jnp.sqrt(-jnp.expm1(2.0 * log_a))
    return a, mult * (i * x).astype(jnp.float32)


def linear_scan(a, b, h0, reverse):
    def comb(l, r):
        al, bl = l
        ar, br = r
        return al * ar, ar * bl + br
    A, Bc = lax.associative_scan(comb, (a, b), axis=1, reverse=reverse)
    return Bc + A * h0.astype(jnp.float32)[:, None, :]


def sublayer(x, shift, scale, gate, ctx_k, ctx_v, h0_f, h0_b, use_rope, layer,
             g_pre, w_in, lq1, lk1, lq2, lk2, g_subln, conv_w, conv_b,
             w_r, b_r, w_i, b_i, lru_lam, w_out, g_post):
    B, T, _ = x.shape
    h = rms_norm(x, g_pre) * (1.0 + scale) + shift
    p = h @ w_in
    q, k, v, g_att, x_lru, g_lru = jnp.split(p, SPLITS, axis=-1)
    q = q.reshape(B, T, N_ATT_HEADS, 2, DIFF_HEAD_DIM)
    k = k.reshape(B, T, N_ATT_HEADS, 2, DIFF_HEAD_DIM)
    v = v.reshape(B, T, N_ATT_HEADS, V_HEAD_DIM)
    if use_rope:
        q = axial_rope(q)
        k = axial_rope(k)
    if ctx_k is None:
        k_all, v_all = k, v
    else:
        k_all = jnp.concatenate([ctx_k, k], axis=1)
        v_all = jnp.concatenate([ctx_v, v], axis=1)
    lam_init = 0.8 - 0.6 * math.exp(-0.3 * layer)
    lam = (jnp.exp(jnp.sum(lq1.astype(jnp.float32) * lk1.astype(jnp.float32)))
           - jnp.exp(jnp.sum(lq2.astype(jnp.float32) * lk2.astype(jnp.float32))) + lam_init)
    o = diff_attention(q, k_all, v_all, lam)
    att = (rms_norm(o, g_subln) * (1.0 - lam_init)).reshape(B, T, D_ATT) * jax.nn.silu(g_att)
    u = centred_conv(x_lru, conv_w, conv_b)
    a_f, b_f = lru_coeffs(u, w_r[0], b_r[0], w_i[0], b_i[0], lru_lam[0])
    a_b, b_b = lru_coeffs(u, w_r[1], b_r[1], w_i[1], b_i[1], lru_lam[1])
    hf = linear_scan(a_f, b_f, h0_f, False)
    hb = linear_scan(a_b, b_b, h0_b, True)
    lru = (hf + hb).astype(x.dtype) * jax.nn.silu(g_lru)
    out = jnp.concatenate([att, lru], axis=-1) @ w_out
    x_new = x + gate * rms_norm(out, g_post)
    k_flat = k.reshape(B, T, N_ATT_HEADS, 2 * DIFF_HEAD_DIM)
    state = jnp.stack([hf[:, -1], hb[:, 0]], axis=1).astype(x.dtype)
    return x_new, k_flat, v, state


def setup_inputs(seed: int = 0) -> dict:
    key = jax.random.key(seed)
    ks = jax.random.split(key, 32)
    f32 = jnp.float32
    nrm = lambda k, s, sc: jax.random.normal(k, s, f32) * sc
    a0 = jax.random.uniform(ks[20], (DEPTH, 2, D_LRU), f32, 0.9, 0.999)
    s0 = a0 ** (1.0 / LRU_C)
    return {
        "x_prompt": nrm(ks[0], (BATCH, SEQ, D_MODEL), 1.0),
        "x_sample": nrm(ks[1], (DEC_BATCH, DEC_SEQ, D_MODEL), 1.0),
        "cache_k": nrm(ks[2], (DEC_BATCH, DEPTH, PAST_LEN, N_ATT_HEADS, 2 * DIFF_HEAD_DIM), 1.0),
        "cache_v": nrm(ks[3], (DEC_BATCH, DEPTH, PAST_LEN, N_ATT_HEADS, V_HEAD_DIM), 1.0),
        "state_lru": nrm(ks[4], (DEC_BATCH, DEPTH, 2, D_LRU), 0.5),
        "c": nrm(ks[5], (DEC_BATCH, D_MODEL), 1.0),
        "c_ctx": nrm(ks[6], (D_MODEL,), 1.0),
        "w_ada": nrm(ks[7], (DEPTH, D_MODEL, 3 * D_MODEL), 0.5 * D_MODEL ** -0.5),
        "b_ada": nrm(ks[8], (DEPTH, 3 * D_MODEL), 0.02),
        "g_pre": 1.0 + nrm(ks[9], (DEPTH, D_MODEL), 0.02),
        "w_in": nrm(ks[10], (DEPTH, D_MODEL, D_IN_TOTAL), D_MODEL ** -0.5),
        "lambda_q1": nrm(ks[11], (DEPTH, DIFF_HEAD_DIM), 0.1),
        "lambda_k1": nrm(ks[12], (DEPTH, DIFF_HEAD_DIM), 0.1),
        "lambda_q2": nrm(ks[13], (DEPTH, DIFF_HEAD_DIM), 0.1),
        "lambda_k2": nrm(ks[14], (DEPTH, DIFF_HEAD_DIM), 0.1),
        "g_subln": 1.0 + nrm(ks[15], (DEPTH, V_HEAD_DIM), 0.02),
        "conv_w": nrm(ks[16], (DEPTH, CONV_WIDTH, D_LRU), CONV_WIDTH ** -0.5),
        "conv_b": nrm(ks[17], (DEPTH, D_LRU), 0.02),
        "w_rgate": nrm(ks[18], (DEPTH, 2, N_LRU_BLOCKS, LRU_BLOCK, LRU_BLOCK), LRU_BLOCK ** -0.5),
        "b_rgate": nrm(ks[19], (DEPTH, 2, D_LRU), 0.02),
        "w_igate": nrm(ks[21], (DEPTH, 2, N_LRU_BLOCKS, LRU_BLOCK, LRU_BLOCK), LRU_BLOCK ** -0.5),
        "b_igate": nrm(ks[22], (DEPTH, 2, D_LRU), 0.02),
        "lru_lambda": jnp.log(s0) - jnp.log1p(-s0),
        "w_out": nrm(ks[23], (DEPTH, D_MIX, D_MODEL), D_MIX ** -0.5),
        "g_post": 1.0 + nrm(ks[24], (DEPTH, D_MODEL), 0.02),
    }


def reference(x_prompt, x_sample, cache_k, cache_v, state_lru, c, c_ctx, w_ada, b_ada, g_pre, w_in,
              lambda_q1, lambda_k1, lambda_q2, lambda_k2, g_subln, conv_w, conv_b,
              w_rgate, b_rgate, w_igate, b_igate, lru_lambda, w_out, g_post):
    y_p = x_prompt
    y_s = x_sample
    Bp = x_prompt.shape[0]
    Bd, Kc = cache_k.shape[0], cache_k.shape[2]
    zeros = jnp.zeros((Bp, D_LRU), jnp.float32)
    new_ks, new_vs, new_sts = [], [], []
    for l in range(DEPTH):
        w = (g_pre[l], w_in[l], lambda_q1[l], lambda_k1[l], lambda_q2[l], lambda_k2[l], g_subln[l],
             conv_w[l], conv_b[l], w_rgate[l], b_rgate[l], w_igate[l], b_igate[l], lru_lambda[l],
             w_out[l], g_post[l])
        sh, sc, gt = modulation(c_ctx, w_ada[l], b_ada[l])
        y_p, k_l, v_l, st_l = sublayer(y_p, sh, sc, gt, None, None, zeros, zeros, False, l, *w)
        new_ks.append(k_l)
        new_vs.append(v_l)
        new_sts.append(st_l)
        sh, sc, gt = modulation(c[:, None, :], w_ada[l], b_ada[l])
        ctx_k = cache_k[:, l].reshape(Bd, Kc, N_ATT_HEADS, 2, DIFF_HEAD_DIM)
        y_s, _, _, _ = sublayer(y_s, sh, sc, gt, ctx_k, cache_v[:, l], state_lru[:, l, 0], state_lru[:, l, 1],
                                True, l, *w)
    new_k = jnp.stack(new_ks, axis=1)
    new_v = jnp.stack(new_vs, axis=1)
    new_state_lru = jnp.stack(new_sts, axis=1)
    return (y_p, y_s, new_k, new_v, new_state_lru)
```

```cpp
#include <hip/hip_runtime.h>
#include <cstdio>
#include <cstdint>

#ifndef MULTI_LAUNCH
#define MULTI_LAUNCH 0
#endif

#define DI __device__ __forceinline__
typedef unsigned short bf16_t;
typedef short bf16x8 __attribute__((ext_vector_type(8)));
typedef float f32x16 __attribute__((ext_vector_type(16)));
typedef float f32x4 __attribute__((ext_vector_type(4)));
typedef float f32x2 __attribute__((ext_vector_type(2)));
typedef unsigned u32x4 __attribute__((ext_vector_type(4)));
typedef unsigned u32x2 __attribute__((ext_vector_type(2)));
typedef __bf16 bf16x2_t __attribute__((ext_vector_type(2)));
#define MFMA32(a, b, c) __builtin_amdgcn_mfma_f32_32x32x16_bf16((a), (b), (c), 0, 0, 0)

constexpr int NTOK = 20480, NCTX = 4096;
constexpr float EPSF = 1e-6f;
constexpr int OUT_YS = 0, OUT_NK = 20971520, OUT_NV = 25165824, OUT_ST = 29360128;

struct Params {
  const float *x_prompt, *x_sample, *cache_k, *cache_v, *state_lru, *c, *c_ctx, *w_ada, *b_ada, *g_pre, *w_in;
  const float *lq1, *lk1, *lq2, *lk2, *g_subln, *conv_w, *conv_b, *w_rgate, *b_rgate, *w_igate, *b_igate, *lru_lambda, *w_out, *g_post;
  float* out;
  float* mod;
  bf16_t* winT;
  bf16_t* woutT;
  bf16_t* wgT;
  bf16_t* h;
  bf16_t* q;
  bf16_t* Kc;
  bf16_t* Ks;
  bf16_t* Vtc;
  bf16_t* Vts;
  bf16_t* gatt;
  bf16_t* xlru;
  bf16_t* glru;
  float* agg;
  float* o2;
  unsigned* bar;
  int phase_lo, phase_hi;
};

DI int lane_id() { return (int)__builtin_amdgcn_mbcnt_hi(~0u, __builtin_amdgcn_mbcnt_lo(~0u, 0u)); }
#define TID_DECL int lane_v_ = lane_id(); asm volatile("" : "+v"(lane_v_)); const int lane = lane_v_; const int wave = wv; const int tid = wave * 64 + lane; (void)tid; (void)lane; (void)wave;
DI unsigned pack2(float lo, float hi) { f32x2 v = {lo, hi}; bf16x2_t b = __builtin_convertvector(v, bf16x2_t); return __builtin_bit_cast(unsigned, b); }
DI float bflo(unsigned u) { return __uint_as_float(u << 16); }
DI float bfhi(unsigned u) { return __uint_as_float(u & 0xffff0000u); }
DI float bf1(bf16_t h) { return __uint_as_float(((unsigned)h) << 16); }
DI bf16_t f2bf(float f) { return (bf16_t)(pack2(f, 0.f) & 0xffffu); }
DI float siluf(float x) { return x / (1.f + __expf(-x)); }
DI float sigm(float x) { return 1.f / (1.f + __expf(-x)); }
DI int crow(int reg, int hh) { return (reg & 3) + 8 * (reg >> 2) + 4 * hh; }
DI const float* xrow(const Params& p, int tok) { return tok < NCTX ? p.x_prompt + (size_t)tok * 1024 : p.x_sample + (size_t)(tok - NCTX) * 1024; }
DI int modidx(int tok) { return tok < NCTX ? 0 : 1 + ((tok - NCTX) >> 12); }

__shared__ __attribute__((aligned(16))) char lds[65536];

DI void transpose_tile(const float* src, size_t sld, bf16_t* dst, size_t dld, int r0, int c0, float* sm, int wv) {
  const int lx = lane_id(), ly = wv;
#pragma unroll
  for (int i = 0; i < 16; ++i) { const int r = ly + 4 * i; sm[r * 65 + lx] = src[(size_t)(r0 + r) * sld + c0 + lx]; }
  __syncthreads();
#pragma unroll
  for (int i = 0; i < 16; ++i) { const int cc = ly + 4 * i; dst[(size_t)(c0 + cc) * dld + r0 + lx] = f2bf(sm[lx * 65 + cc]); }
  __syncthreads();
}

DI void mod_unit(const Params& p, int u, int wv) {
  float* sc = (float*)lds;
  float* red = sc + 5120;
  TID_DECL
  for (int i = tid; i < 5120; i += 256) { const int mi = i >> 10, k = i & 1023; const float cv = (mi == 0) ? p.c_ctx[k] : p.c[(mi - 1) * 1024 + k]; sc[i] = siluf(cv); }
  __syncthreads();
  const int col = tid & 31, kg = tid >> 5, n = u * 32 + col;
  float a0 = 0.f, a1 = 0.f, a2 = 0.f, a3 = 0.f, a4 = 0.f;
#pragma unroll 8
  for (int k = kg * 128; k < kg * 128 + 128; ++k) {
    const float w = p.w_ada[(size_t)k * 3072 + n];
    a0 += sc[k] * w; a1 += sc[1024 + k] * w; a2 += sc[2048 + k] * w; a3 += sc[3072 + k] * w; a4 += sc[4096 + k] * w;
  }
  red[(kg * 5 + 0) * 32 + col] = a0; red[(kg * 5 + 1) * 32 + col] = a1; red[(kg * 5 + 2) * 32 + col] = a2; red[(kg * 5 + 3) * 32 + col] = a3; red[(kg * 5 + 4) * 32 + col] = a4;
  __syncthreads();
  if (tid < 160) { const int mi = tid >> 5, cc = tid & 31; float s = p.b_ada[u * 32 + cc];
#pragma unroll
    for (int g = 0; g < 8; ++g) s += red[(g * 5 + mi) * 32 + cc];
    p.mod[mi * 3072 + u * 32 + cc] = s; }
  __syncthreads();
}

DI void phase0(const Params& p, int wv) {
  constexpr int NU_MOD = 96, NU_WIN = 1536, NU_WOUT = 512, NU_G = 128, NU_CV = 512, NU_CK = 1024;
  constexpr int TOTAL = NU_MOD + NU_WIN + NU_WOUT + NU_G + NU_CV + NU_CK;
  float* sm = (float*)lds;
  for (int u = blockIdx.x; u < TOTAL; u += gridDim.x) {
    int v = u;
    if (v < NU_MOD) { mod_unit(p, v, wv); continue; } v -= NU_MOD;
    if (v < NU_WIN) { const int tr = v / 96, tc = v % 96; transpose_tile(p.w_in, 6144, p.winT, 1024, tr * 64, tc * 64, sm, wv); continue; } v -= NU_WIN;
    if (v < NU_WOUT) { const int tr = v / 16, tc = v % 16; transpose_tile(p.w_out, 1024, p.woutT, 2048, tr * 64, tc * 64, sm, wv); continue; } v -= NU_WOUT;
    if (v < NU_G) { const int mtx = v >> 2, t = v & 3; const int dir = mtx >> 4, gate = (mtx >> 3) & 1, blk = mtx & 7;
      const float* src = (gate ? p.w_igate : p.w_rgate) + (size_t)(dir * 8 + blk) * 16384;
      transpose_tile(src, 128, p.wgT + (size_t)mtx * 16384, 128, (t >> 1) * 64, (t & 1) * 64, sm, wv); continue; } v -= NU_G;
    if (v < NU_CV) { const int bh = v >> 4, t = v & 15; const int b = bh >> 3, hd = bh & 7;
      const float* src = p.cache_v + (size_t)b * 512 * 1024 + hd * 128;
      transpose_tile(src, 1024, p.Vts + (size_t)bh * 128 * 4608, 4608, (t >> 1) * 64, (t & 1) * 64, sm, wv); continue; } v -= NU_CV;
    { const size_t i0 = (size_t)v * 2048 + (wv * 64 + lane_id()) * 8; const size_t b = i0 / (512 * 1024), rem = i0 % (512 * 1024);
      const f32x4 x0 = *(const f32x4*)(p.cache_k + i0), x1 = *(const f32x4*)(p.cache_k + i0 + 4);
      u32x4 w; w.x = pack2(x0[0], x0[1]); w.y = pack2(x0[2], x0[3]); w.z = pack2(x1[0], x1[1]); w.w = pack2(x1[2], x1[3]);
      *(u32x4*)(p.Ks + b * (size_t)4608 * 1024 + rem) = w; }
  }
}

DI void phase1(const Params& p, int wv) {
  TID_DECL
  for (int u = blockIdx.x; u < NTOK / 4; u += gridDim.x) {
    const int tok = u * 4 + wave; const float* x = xrow(p, tok); const float* md = p.mod + modidx(tok) * 3072;
    f32x4 xv[4]; float ss = 0.f;
#pragma unroll
    for (int i = 0; i < 4; ++i) { xv[i] = *(const f32x4*)(x + lane * 4 + 256 * i); ss += xv[i][0] * xv[i][0] + xv[i][1] * xv[i][1] + xv[i][2] * xv[i][2] + xv[i][3] * xv[i][3]; }
#pragma unroll
    for (int o = 32; o >= 1; o >>= 1) ss += __shfl_xor(ss, o);
    const float rstd = rsqrtf(ss * (1.f / 1024.f) + EPSF);
#pragma unroll
    for (int i = 0; i < 4; ++i) { const int col = lane * 4 + 256 * i;
      const f32x4 g = *(const f32x4*)(p.g_pre + col), sh = *(const f32x4*)(md + col), scl = *(const f32x4*)(md + 1024 + col);
      float o[4];
#pragma unroll
      for (int j = 0; j < 4; ++j) o[j] = xv[i][j] * rstd * g[j] * (1.f + scl[j]) + sh[j];
      u32x2 w; w.x = pack2(o[0], o[1]); w.y = pack2(o[2], o[3]);
      *(u32x2*)(p.h + (size_t)tok * 1024 + col) = w; }
  }
}

struct GemmRegs { u32x4 a[4], b[4]; };
DI void g_load(const bf16_t* A, int lda, const bf16_t* Bt, int ldb, int m0, int n0, int k0, GemmRegs& g, int tid) {
#pragma unroll
  for (int i = 0; i < 4; ++i) { const int id = tid + 256 * i, row = id >> 3, ch = id & 7;
    g.a[i] = *(const u32x4*)(A + (size_t)(m0 + row) * lda + (k0 & 1023) + ch * 8);
    g.b[i] = *(const u32x4*)(Bt + (size_t)(n0 + row) * ldb + k0 + ch * 8); }
}
DI void g_store(char* buf, const GemmRegs& g, int tid) {
#pragma unroll
  for (int i = 0; i < 4; ++i) { const int id = tid + 256 * i, row = id >> 3, ch = id & 7; const int off = row * 128 + ((ch ^ ((row >> 1) & 7)) << 4);
    *(u32x4*)(buf + off) = g.a[i]; *(u32x4*)(buf + 16384 + off) = g.b[i]; }
}
DI void g_compute(const char* buf, f32x16 (&acc)[2][2], int wr, int wc, int lane) {
  const int r = lane & 31, hh = lane >> 5;
#pragma unroll
  for (int ks = 0; ks < 4; ++ks) { const int chunk = 2 * ks + hh; bf16x8 af[2], bg[2];
#pragma unroll
    for (int mt = 0; mt < 2; ++mt) { const int row = wr * 64 + mt * 32 + r; af[mt] = *(const bf16x8*)(buf + row * 128 + ((chunk ^ ((row >> 1) & 7)) << 4)); }
#pragma unroll
    for (int nt = 0; nt < 2; ++nt) { const int row = wc * 64 + nt * 32 + r; bg[nt] = *(const bf16x8*)(buf + 16384 + row * 128 + ((chunk ^ ((row >> 1) & 7)) << 4)); }
#pragma unroll
    for (int mt = 0; mt < 2; ++mt)
#pragma unroll
      for (int nt = 0; nt < 2; ++nt) acc[mt][nt] = MFMA32(af[mt], bg[nt], acc[mt][nt]);
  }
}
DI void gemm_tile(const bf16_t* A, const bf16_t* A2, int lda, const bf16_t* Bt, int ldb, int K, int m0, int n0, f32x16 (&acc)[2][2], int wv) {
  TID_DECL const int wr = wave >> 1, wc = wave & 1;
#pragma unroll
  for (int mt = 0; mt < 2; ++mt)
#pragma unroll
    for (int nt = 0; nt < 2; ++nt)
#pragma unroll
      for (int i = 0; i < 16; ++i) acc[mt][nt][i] = 0.f;
  GemmRegs g; const int nk = K >> 6;
  g_load(A, lda, Bt, ldb, m0, n0, 0, g, tid); g_store(lds, g, tid); __syncthreads();
  for (int kt = 0; kt < nk; ++kt) {
    char* cur = lds + (kt & 1) * 32768; char* nxt = lds + ((kt + 1) & 1) * 32768;
    if (kt + 1 < nk) g_load((kt + 1) < 16 ? A : A2, lda, Bt, ldb, m0, n0, (kt + 1) << 6, g, tid);
    g_compute(cur, acc, wr, wc, lane);
    if (kt + 1 < nk) g_store(nxt, g, tid);
    __syncthreads();
  }
}

DI void phase2(const Params& p, int wv) {
  TID_DECL const int wr = wave >> 1, wc = wave & 1, r = lane & 31, hh = lane >> 5;
  constexpr int NT_N = 48, NT_M = 160;
  for (int u = blockIdx.x; u < NT_N * NT_M; u += gridDim.x) {
    const int tm = u / NT_N, tn = u % NT_N; const int m0 = tm * 128, n0 = tn * 128;
    f32x16 acc[2][2];
    gemm_tile(p.h, p.h, 1024, p.winT, 1024, 1024, m0, n0, acc, wv);
    const int ctype = n0 >> 10; const bool ctx = m0 < NCTX;
    const int b = ctx ? (m0 >> 8) : ((m0 - NCTX) >> 12);
#pragma unroll
    for (int mt = 0; mt < 2; ++mt) {
      const int rowbase = m0 + wr * 64 + mt * 32;
      const int tseq = ctx ? (rowbase & 255) : ((rowbase - NCTX) & 4095);
#pragma unroll
      for (int nt = 0; nt < 2; ++nt) {
        const int cin = (n0 & 1023) + wc * 64 + nt * 32 + r;
        f32x16 v = acc[mt][nt];
        if (ctype <= 1) {
          if (!ctx) {
            const int i = lane & 15; const bool second = (lane & 16) != 0;
            const float inv = __builtin_amdgcn_exp2f(-(float)i * 0.8304820237218405f);
#pragma unroll
            for (int reg = 0; reg < 16; ++reg) {
              const int t = tseq + crow(reg, hh);
              const float pos = (nt & 1) ? (float)(t & 63) : (float)(t >> 6);
              const float ang = pos * inv; const float sn = __sinf(ang), cs = __cosf(ang);
              const float x = v[reg]; const float xp = __shfl_xor(x, 16);
              v[reg] = second ? (xp * sn + x * cs) : (x * cs - xp * sn);
            }
          }
          if (ctype == 0) {
#pragma unroll
            for (int reg = 0; reg < 16; ++reg) p.q[(size_t)(rowbase + crow(reg, hh)) * 1024 + cin] = f2bf(v[reg] * 0.18033688011112042f);
          } else {
#pragma unroll
            for (int reg = 0; reg < 16; ++reg) { const int tok = rowbase + crow(reg, hh);
              if (ctx) { p.Kc[(size_t)tok * 1024 + cin] = f2bf(v[reg]); p.out[OUT_NK + (size_t)tok * 1024 + cin] = v[reg]; }
              else { const int t = tseq + crow(reg, hh); p.Ks[((size_t)b * 4608 + 512 + t) * 1024 + cin] = f2bf(v[reg]); } }
          }
        } else if (ctype == 2) {
          const int hd = cin >> 7, e = cin & 127;
          bf16_t* vt = ctx ? p.Vtc + ((size_t)(b * 8 + hd) * 128 + e) * 256 + tseq : p.Vts + ((size_t)(b * 8 + hd) * 128 + e) * 4608 + 512 + tseq;
#pragma unroll
          for (int g = 0; g < 4; ++g) { u32x2 w; w.x = pack2(v[4 * g], v[4 * g + 1]); w.y = pack2(v[4 * g + 2], v[4 * g + 3]); *(u32x2*)(vt + 8 * g + 4 * hh) = w; }
          if (ctx) {
#pragma unroll
            for (int reg = 0; reg < 16; ++reg) p.out[OUT_NV + (size_t)(rowbase + crow(reg, hh)) * 1024 + cin] = v[reg];
          }
        } else {
          bf16_t* dst = (ctype == 3) ? p.gatt : (ctype == 4) ? p.xlru : p.glru;
#pragma unroll
          for (int reg = 0; reg < 16; ++reg) dst[(size_t)(rowbase + crow(reg, hh)) * 1024 + cin] = f2bf(v[reg]);
        }
      }
    }
  }
}

DI float softplusf(float x) { return x > 20.f ? x : log1pf(__expf(x)); }
template <bool PASS2>
DI void lru_unit(const Params& p, int unit, int wv) {
  TID_DECL const int r = lane & 31, hh = lane >> 5;
  const int chunk = unit >> 3, blk = unit & 7; const int tok0 = chunk * 64, ch0 = blk * 128;
  const bool ctx = tok0 < NCTX;
  const int seq_start = ctx ? (tok0 & ~255) : (NCTX + ((tok0 - NCTX) & ~4095)); const int seq_len = ctx ? 256 : 4096;
  const int b = ctx ? (tok0 >> 8) : ((tok0 - NCTX) >> 12);
  char* sU = lds;
  float* sA = (float*)(lds + 16384);
  bf16_t* sB = (bf16_t*)(lds + 49152);
  { const int cc = tid & 15, tg = tid >> 4; const int c8 = ch0 + cc * 8;
    float xin[7][8];
#pragma unroll
    for (int j = 0; j < 7; ++j) { const int tok = tok0 + tg * 4 - 1 + j; const bool ok = tok >= seq_start && tok < seq_start + seq_len;
      u32x4 w = {0u, 0u, 0u, 0u}; if (ok) w = *(const u32x4*)(p.xlru + (size_t)tok * 1024 + c8);
      xin[j][0] = bflo(w.x); xin[j][1] = bfhi(w.x); xin[j][2] = bflo(w.y); xin[j][3] = bfhi(w.y); xin[j][4] = bflo(w.z); xin[j][5] = bfhi(w.z); xin[j][6] = bflo(w.w); xin[j][7] = bfhi(w.w); }
    float cw[4][8], cb[8];
#pragma unroll
    for (int j = 0; j < 4; ++j) { const f32x4 w0 = *(const f32x4*)(p.conv_w + j * 1024 + c8), w1 = *(const f32x4*)(p.conv_w + j * 1024 + c8 + 4);
      cw[j][0] = w0[0]; cw[j][1] = w0[1]; cw[j][2] = w0[2]; cw[j][3] = w0[3]; cw[j][4] = w1[0]; cw[j][5] = w1[1]; cw[j][6] = w1[2]; cw[j][7] = w1[3]; }
    { const f32x4 b0 = *(const f32x4*)(p.conv_b + c8), b1 = *(const f32x4*)(p.conv_b + c8 + 4); cb[0] = b0[0]; cb[1] = b0[1]; cb[2] = b0[2]; cb[3] = b0[3]; cb[4] = b1[0]; cb[5] = b1[1]; cb[6] = b1[2]; cb[7] = b1[3]; }
#pragma unroll
    for (int t = 0; t < 4; ++t) { float uu[8];
#pragma unroll
      for (int e = 0; e < 8; ++e) uu[e] = cb[e] + cw[0][e] * xin[t][e] + cw[1][e] * xin[t + 1][e] + cw[2][e] * xin[t + 2][e] + cw[3][e] * xin[t + 3][e];
      u32x4 w; w.x = pack2(uu[0], uu[1]); w.y = pack2(uu[2], uu[3]); w.z = pack2(uu[4], uu[5]); w.w = pack2(uu[6], uu[7]);
      const int row = tg * 4 + t; *(u32x4*)(sU + row * 256 + ((cc ^ (row & 15)) << 4)) = w; }
  }
  __syncthreads();
  const int chl = wave * 32 + r, ch = ch0 + chl;
  float hfin = 0.f;
#pragma unroll 1
  for (int dir = 0; dir < 2; ++dir) {
    f32x16 acc[2][2];
#pragma unroll
    for (int g = 0; g < 2; ++g)
#pragma unroll
      for (int mt = 0; mt < 2; ++mt)
#pragma unroll
        for (int i = 0; i < 16; ++i) acc[g][mt][i] = 0.f;
    const bf16_t* wr_ = p.wgT + ((size_t)((dir * 2 + 0) * 8 + blk) * 128 + chl) * 128;
    const bf16_t* wi_ = p.wgT + ((size_t)((dir * 2 + 1) * 8 + blk) * 128 + chl) * 128;
#pragma unroll
    for (int ks = 0; ks < 8; ++ks) { const int chunkk = 2 * ks + hh;
      const bf16x8 br = *(const bf16x8*)(wr_ + chunkk * 8), bi = *(const bf16x8*)(wi_ + chunkk * 8);
      bf16x8 af[2];
#pragma unroll
      for (int mt = 0; mt < 2; ++mt) { const int row = mt * 32 + r; af[mt] = *(const bf16x8*)(sU + row * 256 + ((chunkk ^ (row & 15)) << 4)); }
#pragma unroll
      for (int mt = 0; mt < 2; ++mt) { acc[0][mt] = MFMA32(af[mt], br, acc[0][mt]); acc[1][mt] = MFMA32(af[mt], bi, acc[1][mt]); }
    }
    if (dir == 1) __syncthreads();
    const float brg = p.b_rgate[dir * 1024 + ch], big = p.b_igate[dir * 1024 + ch];
    const float sp8 = -8.f * softplusf(-p.lru_lambda[dir * 1024 + ch]);
#pragma unroll
    for (int mt = 0; mt < 2; ++mt)
#pragma unroll
      for (int reg = 0; reg < 16; ++reg) { const int row = mt * 32 + crow(reg, hh);
        const float rg = sigm(acc[0][mt][reg] + brg), ig = sigm(acc[1][mt][reg] + big);
        const float la = sp8 * rg; const float a = __expf(la); const float x2 = 2.f * la;
        const float om = (x2 > -0.05f) ? -x2 * (1.f + 0.5f * x2 * (1.f + (1.f / 3.f) * x2 * (1.f + 0.25f * x2))) : 1.f - a * a;
        bf16_t* up = (bf16_t*)(sU + row * 256 + (((chl >> 3) ^ (row & 15)) << 4) + (chl & 7) * 2);
        const float uv = bf1(*up);
        const float bv = sqrtf(om) * ig * uv;
        sA[row * 128 + chl] = a;
        if (dir == 0) sB[row * 128 + chl] = f2bf(bv); else *up = f2bf(bv);
      }
    __syncthreads();
    if (tid < 128) {
      const int c = tid; const int gch = ch0 + c;
      const int cfirst = seq_start >> 6, clast = (seq_start + seq_len - 64) >> 6;
      float hcar = 0.f;
      if (PASS2) {
        hcar = ctx ? 0.f : p.state_lru[(size_t)b * 2048 + dir * 1024 + gch];
        const float* ag = p.agg + (size_t)dir * 320 * 2048 + gch;
        if (dir == 0) { for (int j = cfirst; j < chunk; ++j) hcar = ag[(size_t)j * 2048] * hcar + ag[(size_t)j * 2048 + 1024]; }
        else { for (int j = clast; j > chunk; --j) hcar = ag[(size_t)j * 2048] * hcar + ag[(size_t)j * 2048 + 1024]; }
      }
      float hv = hcar, ap = 1.f;
      if (dir == 0) {
#pragma unroll 8
        for (int t = 0; t < 64; ++t) { const float a = sA[t * 128 + c]; const float bv = bf1(sB[t * 128 + c]); hv = a * hv + bv; ap *= a; if (PASS2) sB[t * 128 + c] = f2bf(hv); }
        if (PASS2) hfin = hv;
      } else {
#pragma unroll 8
        for (int t = 63; t >= 0; --t) { const float a = sA[t * 128 + c];
          const float bv = bf1(*(const bf16_t*)(sU + t * 256 + (((c >> 3) ^ (t & 15)) << 4) + (c & 7) * 2));
          hv = a * hv + bv; ap *= a; if (PASS2) sA[t * 128 + c] = hv + bf1(sB[t * 128 + c]); }
      }
      if (!PASS2) { float* ag = p.agg + ((size_t)dir * 320 + chunk) * 2048 + gch; ag[0] = ap; ag[1024] = hv; }
      else if (ctx) {
        if (dir == 0 && chunk == clast) p.out[OUT_ST + (size_t)b * 2048 + gch] = hfin;
        if (dir == 1 && chunk == cfirst) p.out[OUT_ST + (size_t)b * 2048 + 1024 + gch] = hv;
      }
    }
    __syncthreads();
  }
  if (PASS2) {
    const int cc = tid & 15, tg = tid >> 4;
#pragma unroll
    for (int t = 0; t < 4; ++t) { const int row = tg * 4 + t; const int tok = tok0 + row;
      const f32x4 s0 = *(const f32x4*)(sA + row * 128 + cc * 8), s1 = *(const f32x4*)(sA + row * 128 + cc * 8 + 4);
      const u32x4 gw = *(const u32x4*)(p.glru + (size_t)tok * 1024 + ch0 + cc * 8);
      u32x4 w;
      w.x = pack2(s0[0] * siluf(bflo(gw.x)), s0[1] * siluf(bfhi(gw.x))); w.y = pack2(s0[2] * siluf(bflo(gw.y)), s0[3] * siluf(bfhi(gw.y)));
      w.z = pack2(s1[0] * siluf(bflo(gw.z)), s1[1] * siluf(bfhi(gw.z))); w.w = pack2(s1[2] * siluf(bflo(gw.w)), s1[3] * siluf(bfhi(gw.w)));
      *(u32x4*)(p.glru + (size_t)tok * 1024 + ch0 + cc * 8) = w; }
    __syncthreads();
  }
}

DI float lambda_full(const Params& p, int lane) {
  float a = p.lq1[lane] * p.lk1[lane], c = p.lq2[lane] * p.lk2[lane];
#pragma unroll
  for (int o = 32; o >= 1; o >>= 1) { a += __shfl_xor(a, o); c += __shfl_xor(c, o); }
  return __expf(a) - __expf(c) + 0.2f;
}
DI int kperm(int r) { return (r & ~12) | ((r & 4) << 1) | ((r & 8) >> 1); }

DI void attn_item(const Params& p, int item, int wv) {
  TID_DECL const int r = lane & 31, hh = lane >> 5;
  bool ctx; int b, hd, qb;
  if (item < 1024) { ctx = false; b = item >> 8; hd = (item >> 5) & 7; qb = item & 31; }
  else { const int it = item - 1024; ctx = true; b = it >> 4; hd = (it >> 1) & 7; qb = it & 1; }
  const int Tk = ctx ? 256 : 4608;
  const bf16_t* Kb = (ctx ? p.Kc + (size_t)b * 256 * 1024 : p.Ks + (size_t)b * 4608 * 1024) + hd * 128;
  const bf16_t* Vb = ctx ? p.Vtc + (size_t)(b * 8 + hd) * 128 * 256 : p.Vts + (size_t)(b * 8 + hd) * 128 * 4608;
  const int tokq0 = (ctx ? b * 256 : NCTX + b * 4096) + qb * 128 + wave * 32; const int tokq = tokq0 + r;
  char* qs = lds + 32768 + wave * 8192;
#pragma unroll 2
  for (int i = 0; i < 8; ++i) { const int id = lane + 64 * i, row = id >> 4, ch = id & 15;
    *(u32x4*)(qs + row * 256 + ((ch ^ (row & 15)) << 4)) = *(const u32x4*)(p.q + (size_t)(tokq0 + row) * 1024 + hd * 128 + ch * 8); }
  __builtin_amdgcn_sched_barrier(0);
  f32x16 O[2][4];
#pragma unroll
  for (int m = 0; m < 2; ++m)
#pragma unroll
    for (int et = 0; et < 4; ++et)
#pragma unroll
      for (int i = 0; i < 16; ++i) O[m][et][i] = 0.f;
  float mrun[2] = {-1e30f, -1e30f}, lsum[2] = {0.f, 0.f};
  const int krow0 = tid >> 4, kch = tid & 15;
  const int vrow0 = tid >> 2, vch = tid & 3;
  u32x4 sk[2], sv[2];
  auto ld_tile = [&](int kt) {
#pragma unroll
    for (int i = 0; i < 2; ++i) {
      sk[i] = *(const u32x4*)(Kb + (size_t)(kt * 32 + krow0 + 16 * i) * 1024 + kch * 8);
      sv[i] = *(const u32x4*)(Vb + (size_t)(vrow0 + 64 * i) * Tk + kt * 32 + vch * 8); }
  };
  auto st_tile = [&](char* buf) {
#pragma unroll
    for (int i = 0; i < 2; ++i) { const int kr = krow0 + 16 * i; *(u32x4*)(buf + kr * 256 + ((kch ^ (kr & 15)) << 4)) = sk[i];
      const int vr = vrow0 + 64 * i; *(u32x4*)(buf + 8192 + vr * 64 + ((vch ^ ((vr >> 2) & 3)) << 4)) = sv[i]; }
  };
  const int nkt = Tk >> 5;
  ld_tile(0); st_tile(lds); __syncthreads();
  const int kr = kperm(r);
  for (int kt = 0; kt < nkt; ++kt) {
    const char* cur = lds + (kt & 1) * 16384; char* nxt = lds + ((kt + 1) & 1) * 16384;
    if (kt + 1 < nkt) ld_tile(kt + 1);
    bf16x8 pf[2][2];
#pragma unroll
    for (int m = 0; m < 2; ++m) {
      f32x16 s;
#pragma unroll
      for (int i = 0; i < 16; ++i) s[i] = 0.f;
#pragma unroll
      for (int ks = 0; ks < 4; ++ks) { const int chunk = m * 8 + 2 * ks + hh;
        const bf16x8 kf = *(const bf16x8*)(cur + kr * 256 + ((chunk ^ (kr & 15)) << 4));
        const bf16x8 qf = *(const bf16x8*)(qs + r * 256 + ((chunk ^ (r & 15)) << 4));
        s = MFMA32(kf, qf, s); }
      __builtin_amdgcn_sched_barrier(0);
      float mx = s[0];
#pragma unroll
      for (int i = 1; i < 16; ++i) mx = fmaxf(mx, s[i]);
      mx = fmaxf(mx, __shfl_xor(mx, 32));
      if (__any(mx > mrun[m] + 8.f)) {
        const float mn = fmaxf(mrun[m], mx); const float alpha = __builtin_amdgcn_exp2f(mrun[m] - mn); mrun[m] = mn; lsum[m] *= alpha;
#pragma unroll
        for (int et = 0; et < 4; ++et)
#pragma unroll
          for (int i = 0; i < 16; ++i) O[m][et][i] *= alpha;
      }
      float ps = 0.f; float pv[16];
#pragma unroll
      for (int i = 0; i < 16; ++i) { pv[i] = __builtin_amdgcn_exp2f(s[i] - mrun[m]); ps += pv[i]; }
      lsum[m] += ps;
#pragma unroll
      for (int s2 = 0; s2 < 2; ++s2) { u32x4 w; w.x = pack2(pv[8 * s2], pv[8 * s2 + 1]); w.y = pack2(pv[8 * s2 + 2], pv[8 * s2 + 3]); w.z = pack2(pv[8 * s2 + 4], pv[8 * s2 + 5]); w.w = pack2(pv[8 * s2 + 6], pv[8 * s2 + 7]);
        pf[m][s2] = __builtin_bit_cast(bf16x8, w); }
      __builtin_amdgcn_sched_barrier(0);
    }
#pragma unroll
    for (int s2 = 0; s2 < 2; ++s2) {
#pragma unroll
      for (int et = 0; et < 4; ++et) { const int vr = et * 32 + r; const int chunk = 2 * s2 + hh;
        const bf16x8 vf = *(const bf16x8*)(cur + 8192 + vr * 64 + ((chunk ^ ((vr >> 2) & 3)) << 4));
        O[0][et] = MFMA32(vf, pf[0][s2], O[0][et]); O[1][et] = MFMA32(vf, pf[1][s2], O[1][et]); }
      __builtin_amdgcn_sched_barrier(0);
    }
    if (kt + 1 < nkt) st_tile(nxt);
    __syncthreads();
  }
  const float lam = lambda_full(p, lane);
  const float l1 = lsum[0] + __shfl_xor(lsum[0], 32), l2 = lsum[1] + __shfl_xor(lsum[1], 32);
  const float i1 = 1.f / l1, i2 = lam / l2;
  float ss = 0.f;
#pragma unroll
  for (int et = 0; et < 4; ++et)
#pragma unroll
    for (int i = 0; i < 16; ++i) { const float o = O[0][et][i] * i1 - O[1][et][i] * i2; O[0][et][i] = o; ss += o * o; }
  ss += __shfl_xor(ss, 32);
  const float rstd = rsqrtf(ss * (1.f / 128.f) + EPSF) * 0.8f;
#pragma unroll
  for (int et = 0; et < 4; ++et)
#pragma unroll
    for (int g = 0; g < 4; ++g) { const int e0 = et * 32 + 8 * g + 4 * hh;
      const f32x4 gs = *(const f32x4*)(p.g_subln + e0);
      const u32x2 ga = *(const u32x2*)(p.gatt + (size_t)tokq * 1024 + hd * 128 + e0);
      const float v0 = O[0][et][4 * g] * rstd * gs[0] * siluf(bflo(ga.x)), v1 = O[0][et][4 * g + 1] * rstd * gs[1] * siluf(bfhi(ga.x));
      const float v2 = O[0][et][4 * g + 2] * rstd * gs[2] * siluf(bflo(ga.y)), v3 = O[0][et][4 * g + 3] * rstd * gs[3] * siluf(bfhi(ga.y));
      u32x2 w; w.x = pack2(v0, v1); w.y = pack2(v2, v3);
      *(u32x2*)(p.gatt + (size_t)tokq * 1024 + hd * 128 + e0) = w; }
}

DI void phase5(const Params& p, int wv) {
  TID_DECL const int wr = wave >> 1, wc = wave & 1, r = lane & 31, hh = lane >> 5;
  for (int u = blockIdx.x; u < 160 * 8; u += gridDim.x) {
    const int tm = u >> 3, tn = u & 7; const int m0 = tm * 128, n0 = tn * 128;
    f32x16 acc[2][2];
    gemm_tile(p.gatt, p.glru, 1024, p.woutT, 2048, 2048, m0, n0, acc, wv);
#pragma unroll
    for (int mt = 0; mt < 2; ++mt)
#pragma unroll
      for (int nt = 0; nt < 2; ++nt)
#pragma unroll
        for (int reg = 0; reg < 16; ++reg) p.o2[(size_t)(m0 + wr * 64 + mt * 32 + crow(reg, hh)) * 1024 + n0 + wc * 64 + nt * 32 + r] = acc[mt][nt][reg];
  }
}

DI void phase6(const Params& p, int wv) {
  TID_DECL
  for (int u = blockIdx.x; u < NTOK / 4; u += gridDim.x) {
    const int tok = u * 4 + wave; const float* x = xrow(p, tok); const float* md = p.mod + modidx(tok) * 3072 + 2048; const float* o = p.o2 + (size_t)tok * 1024;
    f32x4 ov[4]; float ss = 0.f;
#pragma unroll
    for (int i = 0; i < 4; ++i) { ov[i] = *(const f32x4*)(o + lane * 4 + 256 * i); ss += ov[i][0] * ov[i][0] + ov[i][1] * ov[i][1] + ov[i][2] * ov[i][2] + ov[i][3] * ov[i][3]; }
#pragma unroll
    for (int s = 32; s >= 1; s >>= 1) ss += __shfl_xor(ss, s);
    const float rstd = rsqrtf(ss * (1.f / 1024.f) + EPSF);
#pragma unroll
    for (int i = 0; i < 4; ++i) { const int col = lane * 4 + 256 * i;
      const f32x4 g = *(const f32x4*)(p.g_post + col), gt = *(const f32x4*)(md + col), xv = *(const f32x4*)(x + col);
      f32x4 y;
#pragma unroll
      for (int j = 0; j < 4; ++j) y[j] = xv[j] + gt[j] * (ov[i][j] * rstd * g[j]);
      *(f32x4*)(p.out + (size_t)tok * 1024 + col) = y; }
  }
}


#define XB_TMO      128
#define XB_XCNT(j)  (256  + 64 * (j))
#define XB_XSUB(j)  (1280 + 64 * (j))
#define XB_XGEN(j)  (2304 + 64 * (j))
#define XB_TOP      3328
#define XB_TOPGEN   3392
#define XCD_BAR_WORDS 3456
#define XB_SPIN_CAP (1u << 20)
__shared__ uint4 xb_words;
DI unsigned xb_ld(unsigned* p) { return __hip_atomic_load(p, __ATOMIC_RELAXED, __HIP_MEMORY_SCOPE_AGENT); }
DI unsigned xb_add(unsigned* p, unsigned v) { return __hip_atomic_fetch_add(p, v, __ATOMIC_RELAXED, __HIP_MEMORY_SCOPE_AGENT); }
DI unsigned xb_xcc_id() { return (unsigned)__builtin_amdgcn_s_getreg((3 << 11) | 20) & 0xFu; }
#define XB_SPIN(cond, bar) do { unsigned _sp = 0; while (cond) { __builtin_amdgcn_s_sleep(1); \
    if ((++_sp & 255u) == 0u) { if (xb_ld(&(bar)[XB_TMO])) break; if (_sp > XB_SPIN_CAP) { atomicAdd(&(bar)[XB_TMO], 1u); break; } } } } while (0)
DI void xcd_barrier_complete(unsigned* bar, unsigned x, unsigned& nloc, unsigned& nx) {
  const unsigned G = gridDim.x;
  unsigned sum, cnt, mine, sp = 0u;
  for (;;) {
    sum = 0u; cnt = 0u; mine = 0u;
#pragma unroll
    for (unsigned j = 0; j < 16; ++j) { const unsigned c = xb_ld(&bar[XB_XCNT(j)]); sum += c; cnt += (c > 0u) ? 1u : 0u; mine = (j == x) ? c : mine; }
    if (sum == G) break;
    __builtin_amdgcn_s_sleep(1);
    if ((++sp & 255u) == 0u) { if (xb_ld(&bar[XB_TMO])) break; if (sp > XB_SPIN_CAP) { atomicAdd(&bar[XB_TMO], 1u); break; } }
  }
  nloc = mine > 0u ? mine : 1u; nx = cnt > 0u ? cnt : 1u;
}
DI void grid_barrier(unsigned* bar, bool leader) {
  asm volatile("s_waitcnt vmcnt(0)" ::: "memory");
  __syncthreads();
  if (leader) {
    volatile unsigned* st = (volatile unsigned*)&xb_words;
    const unsigned x = xb_xcc_id();
    __builtin_amdgcn_s_waitcnt(0);
    unsigned nloc = st[0], nx = st[1];
    if (nloc == 0u) { xcd_barrier_complete(bar, x, nloc, nx); st[0] = nloc; st[1] = nx; }
    const unsigned old = xb_add(&bar[XB_XSUB(x)], 1u);
    const unsigned gen = old / nloc;
    if (old + 1u == (gen + 1u) * nloc) {
      __builtin_amdgcn_fence(__ATOMIC_RELEASE, "agent");
      asm volatile("s_waitcnt vmcnt(0)" ::: "memory");
      const unsigned og = xb_add(&bar[XB_TOP], 1u);
      const unsigned tg = og / nx;
      if (og + 1u == (tg + 1u) * nx) xb_add(&bar[XB_TOPGEN], 1u);
      else XB_SPIN(xb_ld(&bar[XB_TOPGEN]) == tg, bar);
      __builtin_amdgcn_fence(__ATOMIC_ACQUIRE, "agent");
      xb_add(&bar[XB_XGEN(x)], 1u);
      asm volatile("s_waitcnt vmcnt(0)" ::: "memory");
    } else {
      XB_SPIN(xb_ld(&bar[XB_XGEN(x)]) == gen, bar);
      __builtin_amdgcn_fence(__ATOMIC_ACQUIRE, "agent");
      asm volatile("s_waitcnt vmcnt(0)" ::: "memory");
    }
  }
  __syncthreads();
}

__global__ void __launch_bounds__(256, 2) fwd_megakernel(Params p) {
  const int lo = p.phase_lo, hi = p.phase_hi;
  const int wv = __builtin_amdgcn_readfirstlane((int)(threadIdx.x >> 6));
  const bool leader = (wv == 0) && (lane_id() == 0);
  if (hi - lo > 1) {
    if (leader) { xb_words = make_uint4(0u, 0u, 0u, 0u); (void)xb_add(&p.bar[XB_XCNT(xb_xcc_id())], 1u); }
    __syncthreads();
  }
  if (lo <= 0 && hi > 0) phase0(p, wv);
  if (lo < 1 && hi > 1) grid_barrier(p.bar, leader);
  if (lo <= 1 && hi > 1) phase1(p, wv);
  if (lo < 2 && hi > 2) grid_barrier(p.bar, leader);
  if (lo <= 2 && hi > 2) phase2(p, wv);
  if (lo < 3 && hi > 3) grid_barrier(p.bar, leader);
  if (lo <= 3 && hi > 3) { for (int u = blockIdx.x; u < 2560; u += gridDim.x) lru_unit<false>(p, u, wv); }
  if (lo < 4 && hi > 4) grid_barrier(p.bar, leader);
  if (lo <= 4 && hi > 4) { for (int u = blockIdx.x; u < 1280; u += gridDim.x) attn_item(p, u, wv);
    for (int u = blockIdx.x; u < 2560; u += gridDim.x) lru_unit<true>(p, u, wv); }
  if (lo < 5 && hi > 5) grid_barrier(p.bar, leader);
  if (lo <= 5 && hi > 5) phase5(p, wv);
  if (lo < 6 && hi > 6) grid_barrier(p.bar, leader);
  if (lo <= 6 && hi > 6) phase6(p, wv);
}

extern "C" void kernel_launch(void* const* d_in, const int* in_sizes, int n_in, void* d_out, int out_size, void* d_ws, size_t ws_size, hipStream_t stream) {
  static int grid_blocks = 0;
  if (!grid_blocks) {
    int dev = 0, cus = 0, per_cu = 0;
    hipGetDevice(&dev);
    hipDeviceGetAttribute(&cus, hipDeviceAttributeMultiprocessorCount, dev);
    hipOccupancyMaxActiveBlocksPerMultiprocessor(&per_cu, fwd_megakernel, 256, 0);
    if (per_cu > 2) per_cu = 2;
    if (per_cu < 1) per_cu = 1;
    grid_blocks = cus * per_cu;
  }
  Params p{};
  const float** fp = (const float**)&p;
  for (int i = 0; i < 25; ++i) fp[i] = (const float*)d_in[i];
  p.out = (float*)d_out;
  char* w = (char*)d_ws; size_t off = 0;
  auto take = [&](size_t bytes) { char* r = w + off; off += (bytes + 255) & ~(size_t)255; return r; };
  p.mod = (float*)take(5 * 3072 * 4);
  p.winT = (bf16_t*)take((size_t)6144 * 1024 * 2);
  p.woutT = (bf16_t*)take((size_t)1024 * 2048 * 2);
  p.wgT = (bf16_t*)take((size_t)32 * 16384 * 2);
  p.h = (bf16_t*)d_out;
  p.q = p.h + (size_t)NTOK * 1024;
  p.Kc = (bf16_t*)take((size_t)4096 * 1024 * 2);
  p.Ks = (bf16_t*)take((size_t)4 * 4608 * 1024 * 2);
  p.Vtc = (bf16_t*)take((size_t)16 * 8 * 128 * 256 * 2);
  p.Vts = (bf16_t*)take((size_t)4 * 8 * 128 * 4608 * 2);
  p.gatt = (bf16_t*)take((size_t)NTOK * 1024 * 2);
  p.xlru = (bf16_t*)take((size_t)NTOK * 1024 * 2);
  p.glru = (bf16_t*)take((size_t)NTOK * 1024 * 2);
  p.agg = (float*)take((size_t)2 * 320 * 2048 * 4);
  p.o2 = (float*)d_out;
  p.bar = (unsigned*)take(XCD_BAR_WORDS * 4);
  if (off > ws_size) { fprintf(stderr, "workspace too small: need %zu have %zu\n", off, ws_size); return; }
#if MULTI_LAUNCH
  for (int ph = 0; ph < 7; ++ph) { p.phase_lo = ph; p.phase_hi = ph + 1; hipLaunchKernelGGL(fwd_megakernel, dim3(grid_blocks), dim3(256), 0, stream, p); }
#else
  hipMemsetAsync(p.bar, 0, XCD_BAR_WORDS * 4, stream);
  p.phase_lo = 0; p.phase_hi = 7;
  void* args[] = {&p};
  hipError_t e = hipLaunchCooperativeKernel((void*)fwd_megakernel, dim3(grid_blocks), dim3(256), args, 0, stream);
  if (e != hipSuccess) fprintf(stderr, "cooperative launch failed: %s (grid %d)\n", hipGetErrorString(e), grid_blocks);
#endif
}
```

```cpp
#include <hip/hip_runtime.h>
#include <cstdio>
#include <cstdint>

#ifndef MULTI_LAUNCH
#define MULTI_LAUNCH 0
#endif

#define DI __device__ __forceinline__
typedef unsigned short bf16_t;
typedef short bf16x8 __attribute__((ext_vector_type(8)));
typedef float f32x16 __attribute__((ext_vector_type(16)));
typedef float f32x4 __attribute__((ext_vector_type(4)));
typedef float f32x2 __attribute__((ext_vector_type(2)));
typedef unsigned u32x4 __attribute__((ext_vector_type(4)));
typedef unsigned u32x2 __attribute__((ext_vector_type(2)));
typedef __bf16 bf16x2_t __attribute__((ext_vector_type(2)));
#define MFMA32(a, b, c) __builtin_amdgcn_mfma_f32_32x32x16_bf16((a), (b), (c), 0, 0, 0)

constexpr int NTOK = 20480, NCTX = 4096, NTHR = 512, NWAVE = 8;
constexpr float EPSF = 1e-6f;
constexpr int OUT_NK = 20971520, OUT_NV = 25165824, OUT_ST = 29360128;

struct Params {
  const float *x_prompt, *x_sample, *cache_k, *cache_v, *state_lru, *c, *c_ctx, *w_ada, *b_ada, *g_pre, *w_in;
  const float *lq1, *lk1, *lq2, *lk2, *g_subln, *conv_w, *conv_b, *w_rgate, *b_rgate, *w_igate, *b_igate, *lru_lambda, *w_out, *g_post;
  float* out;
  float* mod;
  bf16_t* winT;
  bf16_t* woutT;
  bf16_t* wgT;
  bf16_t* h;
  bf16_t* q;
  bf16_t* Kc;
  bf16_t* Ks;
  bf16_t* Vtc;
  bf16_t* Vts;
  bf16_t* gatt;
  bf16_t* xlru;
  bf16_t* glru;
  float* agg;
  float* o2;
  unsigned* bar;
  int phase_lo, phase_hi;
};

DI int lane_id() { return (int)__builtin_amdgcn_mbcnt_hi(~0u, __builtin_amdgcn_mbcnt_lo(~0u, 0u)); }
#define TID_DECL int lane_v_ = lane_id(); asm volatile("" : "+v"(lane_v_)); const int lane = lane_v_; const int wave = wv; const int tid = wave * 64 + lane; (void)tid; (void)lane; (void)wave;
DI unsigned pack2(float lo, float hi) { f32x2 v = {lo, hi}; bf16x2_t b = __builtin_convertvector(v, bf16x2_t); return __builtin_bit_cast(unsigned, b); }
DI float bflo(unsigned u) { return __uint_as_float(u << 16); }
DI float bfhi(unsigned u) { return __uint_as_float(u & 0xffff0000u); }
DI float bf1(bf16_t h) { return __uint_as_float(((unsigned)h) << 16); }
DI bf16_t f2bf(float f) { return (bf16_t)(pack2(f, 0.f) & 0xffffu); }
DI float siluf(float x) { return x / (1.f + __expf(-x)); }
DI float sigm(float x) { return 1.f / (1.f + __expf(-x)); }
DI int crow(int reg, int hh) { return (reg & 3) + 8 * (reg >> 2) + 4 * hh; }
DI const float* xrow(const Params& p, int tok) { return tok < NCTX ? p.x_prompt + (size_t)tok * 1024 : p.x_sample + (size_t)(tok - NCTX) * 1024; }
DI int modidx(int tok) { return tok < NCTX ? 0 : 1 + ((tok - NCTX) >> 12); }

__shared__ __attribute__((aligned(16))) char lds[131072];

DI void transpose_tile(const float* src, size_t sld, bf16_t* dst, size_t dld, int r0, int c0, float* sm, int wv) {
  const int lx = lane_id(), ly = wv;
#pragma unroll
  for (int i = 0; i < 8; ++i) { const int r = ly + 8 * i; sm[r * 65 + lx] = src[(size_t)(r0 + r) * sld + c0 + lx]; }
  __syncthreads();
  const int rp = lx & 31, cs = lx >> 5;
#pragma unroll
  for (int i = 0; i < 4; ++i) { const int cc = cs + 2 * ly + 16 * i;
    *(unsigned*)(dst + (size_t)(c0 + cc) * dld + r0 + 2 * rp) = pack2(sm[(2 * rp) * 65 + cc], sm[(2 * rp + 1) * 65 + cc]); }
  __syncthreads();
}

DI void mod_unit(const Params& p, int u, int wv) {
  float* sc = (float*)lds;
  float* red = sc + 5120;
  TID_DECL
  for (int i = tid; i < 5120; i += NTHR) { const int mi = i >> 10, k = i & 1023; const float cv = (mi == 0) ? p.c_ctx[k] : p.c[(mi - 1) * 1024 + k]; sc[i] = siluf(cv); }
  __syncthreads();
  const int col = tid & 31, kg = tid >> 5, n = u * 32 + col;
  float a0 = 0.f, a1 = 0.f, a2 = 0.f, a3 = 0.f, a4 = 0.f;
#pragma unroll 8
  for (int k = kg * 64; k < kg * 64 + 64; ++k) {
    const float w = p.w_ada[(size_t)k * 3072 + n];
    a0 += sc[k] * w; a1 += sc[1024 + k] * w; a2 += sc[2048 + k] * w; a3 += sc[3072 + k] * w; a4 += sc[4096 + k] * w;
  }
  red[(kg * 5 + 0) * 32 + col] = a0; red[(kg * 5 + 1) * 32 + col] = a1; red[(kg * 5 + 2) * 32 + col] = a2; red[(kg * 5 + 3) * 32 + col] = a3; red[(kg * 5 + 4) * 32 + col] = a4;
  __syncthreads();
  if (tid < 160) { const int mi = tid >> 5, cc = tid & 31; float s = p.b_ada[u * 32 + cc];
#pragma unroll
    for (int g = 0; g < 16; ++g) s += red[(g * 5 + mi) * 32 + cc];
    p.mod[mi * 3072 + u * 32 + cc] = s; }
  __syncthreads();
}

DI void phase0(const Params& p, int wv) {
  constexpr int NU_MOD = 96, NU_WIN = 1536, NU_WOUT = 512, NU_G = 128, NU_CV = 512, NU_CK = 512;
  constexpr int TOTAL = NU_MOD + NU_WIN + NU_WOUT + NU_G + NU_CV + NU_CK;
  float* sm = (float*)lds;
  for (int u = blockIdx.x; u < TOTAL; u += gridDim.x) {
    int v = u;
    if (v < NU_MOD) { mod_unit(p, v, wv); continue; } v -= NU_MOD;
    if (v < NU_WIN) { const int tr = v / 96, tc = v % 96; transpose_tile(p.w_in, 6144, p.winT, 1024, tr * 64, tc * 64, sm, wv); continue; } v -= NU_WIN;
    if (v < NU_WOUT) { const int tr = v / 16, tc = v % 16; transpose_tile(p.w_out, 1024, p.woutT, 2048, tr * 64, tc * 64, sm, wv); continue; } v -= NU_WOUT;
    if (v < NU_G) { const int mtx = v >> 2, t = v & 3; const int dir = mtx >> 4, gate = (mtx >> 3) & 1, blk = mtx & 7;
      const float* src = (gate ? p.w_igate : p.w_rgate) + (size_t)(dir * 8 + blk) * 16384;
      transpose_tile(src, 128, p.wgT + (size_t)mtx * 16384, 128, (t >> 1) * 64, (t & 1) * 64, sm, wv); continue; } v -= NU_G;
    if (v < NU_CV) { const int bh = v >> 4, t = v & 15; const int b = bh >> 3, hd = bh & 7;
      const float* src = p.cache_v + (size_t)b * 512 * 1024 + hd * 128;
      transpose_tile(src, 1024, p.Vts + (size_t)bh * 128 * 4608, 4608, (t >> 1) * 64, (t & 1) * 64, sm, wv); continue; } v -= NU_CV;
    { const size_t i0 = (size_t)v * 4096 + (wv * 64 + lane_id()) * 8; const size_t b = i0 / (512 * 1024), rem = i0 % (512 * 1024);
      const f32x4 x0 = *(const f32x4*)(p.cache_k + i0), x1 = *(const f32x4*)(p.cache_k + i0 + 4);
      u32x4 w; w.x = pack2(x0[0], x0[1]); w.y = pack2(x0[2], x0[3]); w.z = pack2(x1[0], x1[1]); w.w = pack2(x1[2], x1[3]);
      *(u32x4*)(p.Ks + b * (size_t)4608 * 1024 + rem) = w; }
  }
}

DI void phase1(const Params& p, int wv) {
  TID_DECL
  for (int u = blockIdx.x; u < NTOK / NWAVE; u += gridDim.x) {
    const int tok = u * NWAVE + wave; const float* x = xrow(p, tok); const float* md = p.mod + modidx(tok) * 3072;
    f32x4 xv[4]; float ss = 0.f;
#pragma unroll
    for (int i = 0; i < 4; ++i) { xv[i] = *(const f32x4*)(x + lane * 4 + 256 * i); ss += xv[i][0] * xv[i][0] + xv[i][1] * xv[i][1] + xv[i][2] * xv[i][2] + xv[i][3] * xv[i][3]; }
#pragma unroll
    for (int o = 32; o >= 1; o >>= 1) ss += __shfl_xor(ss, o);
    const float rstd = rsqrtf(ss * (1.f / 1024.f) + EPSF);
#pragma unroll
    for (int i = 0; i < 4; ++i) { const int col = lane * 4 + 256 * i;
      const f32x4 g = *(const f32x4*)(p.g_pre + col), sh = *(const f32x4*)(md + col), scl = *(const f32x4*)(md + 1024 + col);
      float o[4];
#pragma unroll
      for (int j = 0; j < 4; ++j) o[j] = xv[i][j] * rstd * g[j] * (1.f + scl[j]) + sh[j];
      u32x2 w; w.x = pack2(o[0], o[1]); w.y = pack2(o[2], o[3]);
      *(u32x2*)(p.h + (size_t)tok * 1024 + col) = w; }
  }
}

template <int MT> struct GemmRegs { u32x4 a[MT], b[4]; };
template <int MT>
DI void g_load(const bf16_t* A, int lda, const bf16_t* Bt, int ldb, int m0, int n0, int k0, GemmRegs<MT>& g, int tid) {
#pragma unroll
  for (int i = 0; i < MT; ++i) { const int id = tid + NTHR * i, row = id >> 3, ch = id & 7; g.a[i] = *(const u32x4*)(A + (size_t)(m0 + row) * lda + (k0 & 1023) + ch * 8); }
#pragma unroll
  for (int i = 0; i < 4; ++i) { const int id = tid + NTHR * i, row = id >> 3, ch = id & 7; g.b[i] = *(const u32x4*)(Bt + (size_t)(n0 + row) * ldb + k0 + ch * 8); }
}
template <int MT>
DI void g_store(char* buf, const GemmRegs<MT>& g, int tid) {
#pragma unroll
  for (int i = 0; i < MT; ++i) { const int id = tid + NTHR * i, row = id >> 3, ch = id & 7; *(u32x4*)(buf + row * 128 + ((ch ^ ((row >> 1) & 7)) << 4)) = g.a[i]; }
#pragma unroll
  for (int i = 0; i < 4; ++i) { const int id = tid + NTHR * i, row = id >> 3, ch = id & 7; *(u32x4*)(buf + MT * 8192 + row * 128 + ((ch ^ ((row >> 1) & 7)) << 4)) = g.b[i]; }
}
template <int MT>
DI void g_compute(const char* buf, f32x16 (&acc)[MT][2], int wr, int wc, int lane) {
  const int r = lane & 31, hh = lane >> 5;
#pragma unroll
  for (int ks = 0; ks < 4; ++ks) { const int chunk = 2 * ks + hh; bf16x8 af[MT], bg[2];
#pragma unroll
    for (int mt = 0; mt < MT; ++mt) { const int row = wr * (32 * MT) + mt * 32 + r; af[mt] = *(const bf16x8*)(buf + row * 128 + ((chunk ^ ((row >> 1) & 7)) << 4)); }
#pragma unroll
    for (int nt = 0; nt < 2; ++nt) { const int row = wc * 64 + nt * 32 + r; bg[nt] = *(const bf16x8*)(buf + MT * 8192 + row * 128 + ((chunk ^ ((row >> 1) & 7)) << 4)); }
#pragma unroll
    for (int mt = 0; mt < MT; ++mt)
#pragma unroll
      for (int nt = 0; nt < 2; ++nt) acc[mt][nt] = MFMA32(af[mt], bg[nt], acc[mt][nt]);
  }
}
template <int MT>
DI void gemm_tile(const bf16_t* A, const bf16_t* A2, int lda, const bf16_t* Bt, int ldb, int K, int m0, int n0, f32x16 (&acc)[MT][2], int wv) {
  TID_DECL const int wr = wave >> 2, wc = wave & 3;
  constexpr int STAGE = MT * 8192 + 32768;
#pragma unroll
  for (int mt = 0; mt < MT; ++mt)
#pragma unroll
    for (int nt = 0; nt < 2; ++nt)
#pragma unroll
      for (int i = 0; i < 16; ++i) acc[mt][nt][i] = 0.f;
  GemmRegs<MT> g; const int nk = K >> 6;
  g_load<MT>(A, lda, Bt, ldb, m0, n0, 0, g, tid); g_store<MT>(lds, g, tid); __syncthreads();
  for (int kt = 0; kt < nk; ++kt) {
    char* cur = lds + (kt & 1) * STAGE; char* nxt = lds + ((kt + 1) & 1) * STAGE;
    if (kt + 1 < nk) g_load<MT>((kt + 1) < 16 ? A : A2, lda, Bt, ldb, m0, n0, (kt + 1) << 6, g, tid);
    g_compute<MT>(cur, acc, wr, wc, lane);
    if (kt + 1 < nk) g_store<MT>(nxt, g, tid);
    __syncthreads();
  }
}

DI void phase2(const Params& p, int wv) {
  TID_DECL const int wr = wave >> 2, wc = wave & 3, r = lane & 31, hh = lane >> 5;
  constexpr int NT_N = 24, NT_M = 80;
  for (int u = blockIdx.x; u < NT_N * NT_M; u += gridDim.x) {
    const int tm = u / NT_N, tn = u % NT_N; const int m0 = tm * 256, n0 = tn * 256;
    f32x16 acc[4][2];
    gemm_tile<4>(p.h, p.h, 1024, p.winT, 1024, 1024, m0, n0, acc, wv);
    const int ctype = n0 >> 10; const bool ctx = m0 < NCTX;
    const int b = ctx ? (m0 >> 8) : ((m0 - NCTX) >> 12);
#pragma unroll
    for (int mt = 0; mt < 4; ++mt) {
      const int rowbase = m0 + wr * 128 + mt * 32;
      const int tseq = ctx ? (rowbase & 255) : ((rowbase - NCTX) & 4095);
#pragma unroll
      for (int nt = 0; nt < 2; ++nt) {
        const int cin = (n0 & 1023) + wc * 64 + nt * 32 + r;
        f32x16 v = acc[mt][nt];
        if (ctype <= 1) {
          if (!ctx) {
            const int i = lane & 15; const bool second = (lane & 16) != 0;
            const float inv = __builtin_amdgcn_exp2f(-(float)i * 0.8304820237218405f);
#pragma unroll
            for (int reg = 0; reg < 16; ++reg) {
              const int t = tseq + crow(reg, hh);
              const float pos = (nt & 1) ? (float)(t & 63) : (float)(t >> 6);
              const float ang = pos * inv; const float sn = __sinf(ang), cs = __cosf(ang);
              const float x = v[reg]; const float xp = __shfl_xor(x, 16);
              v[reg] = second ? (xp * sn + x * cs) : (x * cs - xp * sn);
            }
          }
          if (ctype == 0) {
#pragma unroll
            for (int reg = 0; reg < 16; ++reg) p.q[(size_t)(rowbase + crow(reg, hh)) * 1024 + cin] = f2bf(v[reg] * 0.18033688011112042f);
          } else {
#pragma unroll
            for (int reg = 0; reg < 16; ++reg) { const int tok = rowbase + crow(reg, hh);
              if (ctx) { p.Kc[(size_t)tok * 1024 + cin] = f2bf(v[reg]); p.out[OUT_NK + (size_t)tok * 1024 + cin] = v[reg]; }
              else { const int t = tseq + crow(reg, hh); p.Ks[((size_t)b * 4608 + 512 + t) * 1024 + cin] = f2bf(v[reg]); } }
          }
        } else if (ctype == 2) {
          const int hd = cin >> 7, e = cin & 127;
          bf16_t* vt = ctx ? p.Vtc + ((size_t)(b * 8 + hd) * 128 + e) * 256 + tseq : p.Vts + ((size_t)(b * 8 + hd) * 128 + e) * 4608 + 512 + tseq;
#pragma unroll
          for (int g = 0; g < 4; ++g) { u32x2 w; w.x = pack2(v[4 * g], v[4 * g + 1]); w.y = pack2(v[4 * g + 2], v[4 * g + 3]); *(u32x2*)(vt + 8 * g + 4 * hh) = w; }
          if (ctx) {
#pragma unroll
            for (int reg = 0; reg < 16; ++reg) p.out[OUT_NV + (size_t)(rowbase + crow(reg, hh)) * 1024 + cin] = v[reg];
          }
        } else {
          bf16_t* dst = (ctype == 3) ? p.gatt : (ctype == 4) ? p.xlru : p.glru;
#pragma unroll
          for (int reg = 0; reg < 16; ++reg) dst[(size_t)(rowbase + crow(reg, hh)) * 1024 + cin] = f2bf(v[reg]);
        }
      }
    }
  }
}

DI float softplusf(float x) { return x > 20.f ? x : log1pf(__expf(x)); }
template <bool PASS2>
DI void lru_unit(const Params& p, int unit, int wv) {
  TID_DECL const int r = lane & 31, hh = lane >> 5;
  const int c2 = unit >> 3, blk = unit & 7; const int tok0 = c2 * 128, ch0 = blk * 128;
  const bool ctx = tok0 < NCTX;
  const int seq_start = ctx ? (tok0 & ~255) : (NCTX + ((tok0 - NCTX) & ~4095)); const int seq_len = ctx ? 256 : 4096;
  const int b = ctx ? (tok0 >> 8) : ((tok0 - NCTX) >> 12);
  char* sU = lds;
  float* sS = (float*)(lds + 32768);
  { const int cc = tid & 15, tg = tid >> 4; const int c8 = ch0 + cc * 8;
    float xin[7][8];
#pragma unroll
    for (int j = 0; j < 7; ++j) { const int tok = tok0 + tg * 4 - 1 + j; const bool ok = tok >= seq_start && tok < seq_start + seq_len;
      u32x4 w = {0u, 0u, 0u, 0u}; if (ok) w = *(const u32x4*)(p.xlru + (size_t)tok * 1024 + c8);
      xin[j][0] = bflo(w.x); xin[j][1] = bfhi(w.x); xin[j][2] = bflo(w.y); xin[j][3] = bfhi(w.y); xin[j][4] = bflo(w.z); xin[j][5] = bfhi(w.z); xin[j][6] = bflo(w.w); xin[j][7] = bfhi(w.w); }
    float cw[4][8], cb[8];
#pragma unroll
    for (int j = 0; j < 4; ++j) { const f32x4 w0 = *(const f32x4*)(p.conv_w + j * 1024 + c8), w1 = *(const f32x4*)(p.conv_w + j * 1024 + c8 + 4);
      cw[j][0] = w0[0]; cw[j][1] = w0[1]; cw[j][2] = w0[2]; cw[j][3] = w0[3]; cw[j][4] = w1[0]; cw[j][5] = w1[1]; cw[j][6] = w1[2]; cw[j][7] = w1[3]; }
    { const f32x4 b0 = *(const f32x4*)(p.conv_b + c8), b1 = *(const f32x4*)(p.conv_b + c8 + 4); cb[0] = b0[0]; cb[1] = b0[1]; cb[2] = b0[2]; cb[3] = b0[3]; cb[4] = b1[0]; cb[5] = b1[1]; cb[6] = b1[2]; cb[7] = b1[3]; }
#pragma unroll
    for (int t = 0; t < 4; ++t) { float uu[8];
#pragma unroll
      for (int e = 0; e < 8; ++e) uu[e] = cb[e] + cw[0][e] * xin[t][e] + cw[1][e] * xin[t + 1][e] + cw[2][e] * xin[t + 2][e] + cw[3][e] * xin[t + 3][e];
      u32x4 w; w.x = pack2(uu[0], uu[1]); w.y = pack2(uu[2], uu[3]); w.z = pack2(uu[4], uu[5]); w.w = pack2(uu[6], uu[7]);
      const int row = tg * 4 + t; *(u32x4*)(sU + row * 256 + ((cc ^ (row & 15)) << 4)) = w; }
  }
  __syncthreads();
  const int cg = wave & 3, th = wave >> 2;
  const int chl = cg * 32 + r, ch = ch0 + chl;
  const int chunk = c2 * 2 + th;
  const int cfirst = seq_start >> 6, clast = (seq_start + seq_len - 64) >> 6;
  float hf[2][16];
#pragma unroll
  for (int dir = 0; dir < 2; ++dir) {
    __builtin_amdgcn_sched_barrier(0);
    f32x16 acc[2][2];
#pragma unroll
    for (int g = 0; g < 2; ++g)
#pragma unroll
      for (int mt = 0; mt < 2; ++mt)
#pragma unroll
        for (int i = 0; i < 16; ++i) acc[g][mt][i] = 0.f;
    const bf16_t* wr_ = p.wgT + ((size_t)((dir * 2 + 0) * 8 + blk) * 128 + chl) * 128;
    const bf16_t* wi_ = p.wgT + ((size_t)((dir * 2 + 1) * 8 + blk) * 128 + chl) * 128;
#pragma unroll
    for (int ks = 0; ks < 8; ++ks) { const int chunkk = 2 * ks + hh;
      const bf16x8 br = *(const bf16x8*)(wr_ + chunkk * 8), bi = *(const bf16x8*)(wi_ + chunkk * 8);
      bf16x8 af[2];
#pragma unroll
      for (int mt = 0; mt < 2; ++mt) { const int row = th * 64 + mt * 32 + r; af[mt] = *(const bf16x8*)(sU + row * 256 + ((chunkk ^ (row & 15)) << 4)); }
#pragma unroll
      for (int mt = 0; mt < 2; ++mt) { acc[0][mt] = MFMA32(af[mt], br, acc[0][mt]); acc[1][mt] = MFMA32(af[mt], bi, acc[1][mt]); }
    }
    __builtin_amdgcn_sched_barrier(0);
    const float brg = p.b_rgate[dir * 1024 + ch], big = p.b_igate[dir * 1024 + ch];
    const float sp8 = -8.f * softplusf(-p.lru_lambda[dir * 1024 + ch]);
#pragma unroll
    for (int mt = 0; mt < 2; ++mt)
#pragma unroll
      for (int reg = 0; reg < 16; ++reg) { const int row = th * 64 + mt * 32 + crow(reg, hh);
        const float rg = sigm(acc[0][mt][reg] + brg), ig = sigm(acc[1][mt][reg] + big);
        const float a = __expf(sp8 * rg);
        const float om = (1.f - a) * (1.f + a);
        const float uv = bf1(*(const bf16_t*)(sU + row * 256 + (((chl >> 3) ^ (row & 15)) << 4) + (chl & 7) * 2));
        acc[0][mt][reg] = a; acc[1][mt][reg] = sqrtf(om) * ig * uv; }
    __builtin_amdgcn_sched_barrier(0);
    float GA[8], GB[8], OA[8], OB[8];
#pragma unroll
    for (int mt = 0; mt < 2; ++mt)
#pragma unroll
      for (int g = 0; g < 4; ++g) { const int i = mt * 4 + g;
        const float a0 = acc[0][mt][4 * g], a1 = acc[0][mt][4 * g + 1], a2 = acc[0][mt][4 * g + 2], a3 = acc[0][mt][4 * g + 3];
        const float b0 = acc[1][mt][4 * g], b1 = acc[1][mt][4 * g + 1], b2 = acc[1][mt][4 * g + 2], b3 = acc[1][mt][4 * g + 3];
        GA[i] = (a0 * a1) * (a2 * a3);
        GB[i] = (dir == 0) ? ((b0 * a1 + b1) * a2 + b2) * a3 + b3 : ((b3 * a2 + b2) * a1 + b1) * a0 + b0;
        OA[i] = __shfl_xor(GA[i], 32); OB[i] = __shfl_xor(GB[i], 32); }
    const bool mefirst = (dir == 0) ? (hh == 0) : (hh == 1);
    float hcar = 0.f;
    if (PASS2) {
      hcar = ctx ? 0.f : p.state_lru[(size_t)b * 2048 + dir * 1024 + ch];
      const float* ag = p.agg + (size_t)dir * 320 * 2048 + ch;
      if (dir == 0) { for (int j = cfirst; j < chunk; ++j) hcar = ag[(size_t)j * 2048] * hcar + ag[(size_t)j * 2048 + 1024]; }
      else { for (int j = clast; j > chunk; --j) hcar = ag[(size_t)j * 2048] * hcar + ag[(size_t)j * 2048 + 1024]; }
    }
    float cin_[8]; float ap = 1.f; float cur = hcar;
#pragma unroll
    for (int ii = 0; ii < 8; ++ii) { const int i = (dir == 0) ? ii : 7 - ii;
      const float fA = mefirst ? GA[i] : OA[i], fB = mefirst ? GB[i] : OB[i], sA_ = mefirst ? OA[i] : GA[i], sB_ = mefirst ? OB[i] : GB[i];
      cin_[i] = mefirst ? cur : (fA * cur + fB);
      cur = sA_ * (fA * cur + fB) + sB_; ap *= fA * sA_; }
    if (!PASS2) { if (hh == 0) { float* ag = p.agg + ((size_t)dir * 320 + chunk) * 2048 + ch; ag[0] = ap; ag[1024] = cur; } }
    else {
#pragma unroll
      for (int mt = 0; mt < 2; ++mt)
#pragma unroll
        for (int g = 0; g < 4; ++g) { const int i = mt * 4 + g; float hv = cin_[i];
          if (dir == 0) {
#pragma unroll
            for (int j = 0; j < 4; ++j) { hv = acc[0][mt][4 * g + j] * hv + acc[1][mt][4 * g + j]; hf[mt][4 * g + j] = hv; }
          } else {
#pragma unroll
            for (int j = 3; j >= 0; --j) { hv = acc[0][mt][4 * g + j] * hv + acc[1][mt][4 * g + j]; hf[mt][4 * g + j] += hv; }
            if (ctx && chunk == cfirst && mt == 0 && g == 0 && hh == 0) p.out[OUT_ST + (size_t)b * 2048 + 1024 + ch] = hv;
          }
        }
      if (dir == 0 && ctx && chunk == clast && hh == 1) p.out[OUT_ST + (size_t)b * 2048 + ch] = hf[1][15];
    }
  }
  if (PASS2) {
#pragma unroll
    for (int mt = 0; mt < 2; ++mt)
#pragma unroll
      for (int reg = 0; reg < 16; ++reg) sS[(th * 64 + mt * 32 + crow(reg, hh)) * 128 + chl] = hf[mt][reg];
    __syncthreads();
    const int cc = tid & 15, tg = tid >> 4;
#pragma unroll
    for (int t = 0; t < 4; ++t) { const int row = tg * 4 + t; const int tok = tok0 + row;
      const f32x4 s0 = *(const f32x4*)(sS + row * 128 + cc * 8), s1 = *(const f32x4*)(sS + row * 128 + cc * 8 + 4);
      const u32x4 gw = *(const u32x4*)(p.glru + (size_t)tok * 1024 + ch0 + cc * 8);
      u32x4 w;
      w.x = pack2(s0[0] * siluf(bflo(gw.x)), s0[1] * siluf(bfhi(gw.x))); w.y = pack2(s0[2] * siluf(bflo(gw.y)), s0[3] * siluf(bfhi(gw.y)));
      w.z = pack2(s1[0] * siluf(bflo(gw.z)), s1[1] * siluf(bfhi(gw.z))); w.w = pack2(s1[2] * siluf(bflo(gw.w)), s1[3] * siluf(bfhi(gw.w)));
      *(u32x4*)(p.glru + (size_t)tok * 1024 + ch0 + cc * 8) = w; }
  }
  __syncthreads();
}

DI float lambda_full(const Params& p, int lane) {
  float a = p.lq1[lane] * p.lk1[lane], c = p.lq2[lane] * p.lk2[lane];
#pragma unroll
  for (int o = 32; o >= 1; o >>= 1) { a += __shfl_xor(a, o); c += __shfl_xor(c, o); }
  return __expf(a) - __expf(c) + 0.2f;
}
DI int kperm(int r) { return (r & ~12) | ((r & 4) << 1) | ((r & 8) >> 1); }

DI void attn_item(const Params& p, bool ctx, int b, int hd, int qb, int wv) {
  TID_DECL const int r = lane & 31, hh = lane >> 5;
  const int Tk = ctx ? 256 : 4608;
  const bf16_t* Kb = (ctx ? p.Kc + (size_t)b * 256 * 1024 : p.Ks + (size_t)b * 4608 * 1024) + hd * 128;
  const bf16_t* Vb = ctx ? p.Vtc + (size_t)(b * 8 + hd) * 128 * 256 : p.Vts + (size_t)(b * 8 + hd) * 128 * 4608;
  const int tokq0 = (ctx ? b * 256 : NCTX + b * 4096) + qb * 256 + wave * 32; const int tokq = tokq0 + r;
  char* qs = lds + 65536 + wave * 8192;
#pragma unroll 2
  for (int i = 0; i < 8; ++i) { const int id = lane + 64 * i, row = id >> 4, ch = id & 15;
    *(u32x4*)(qs + row * 256 + ((ch ^ (row & 15)) << 4)) = *(const u32x4*)(p.q + (size_t)(tokq0 + row) * 1024 + hd * 128 + ch * 8); }
  __builtin_amdgcn_sched_barrier(0);
  f32x16 O[2][4];
#pragma unroll
  for (int m = 0; m < 2; ++m)
#pragma unroll
    for (int et = 0; et < 4; ++et)
#pragma unroll
      for (int i = 0; i < 16; ++i) O[m][et][i] = 0.f;
  float mrun[2] = {-1e30f, -1e30f}, lsum[2] = {0.f, 0.f};
  const int krow0 = tid >> 4, kch = tid & 15;
  const int vrow0 = tid >> 3, vch = tid & 7;
  u32x4 sk[2], sv[2];
  auto ld_tile = [&](int kt) {
#pragma unroll
    for (int i = 0; i < 2; ++i) {
      sk[i] = *(const u32x4*)(Kb + (size_t)(kt * 64 + krow0 + 32 * i) * 1024 + kch * 8);
      sv[i] = *(const u32x4*)(Vb + (size_t)(vrow0 + 64 * i) * Tk + kt * 64 + vch * 8); }
  };
  auto st_tile = [&](char* buf) {
#pragma unroll
    for (int i = 0; i < 2; ++i) { const int kr_ = krow0 + 32 * i; *(u32x4*)(buf + kr_ * 256 + ((kch ^ (kr_ & 15)) << 4)) = sk[i];
      const int vr = vrow0 + 64 * i; *(u32x4*)(buf + 16384 + vr * 128 + ((vch ^ ((vr >> 1) & 7)) << 4)) = sv[i]; }
  };
  const int nkt = Tk >> 6;
  ld_tile(0); st_tile(lds); __syncthreads();
  const int kr = kperm(r);
  for (int kt = 0; kt < nkt; ++kt) {
    const char* cur = lds + (kt & 1) * 32768; char* nxt = lds + ((kt + 1) & 1) * 32768;
    if (kt + 1 < nkt) ld_tile(kt + 1);
#pragma unroll
    for (int sub = 0; sub < 2; ++sub) {
      f32x16 s[2];
#pragma unroll
      for (int m = 0; m < 2; ++m)
#pragma unroll
        for (int i = 0; i < 16; ++i) s[m][i] = 0.f;
      const int krow = sub * 32 + kr;
#pragma unroll
      for (int ks = 0; ks < 4; ++ks)
#pragma unroll
        for (int m = 0; m < 2; ++m) { const int chunk = m * 8 + 2 * ks + hh;
          const bf16x8 kf = *(const bf16x8*)(cur + krow * 256 + ((chunk ^ (krow & 15)) << 4));
          const bf16x8 qf = *(const bf16x8*)(qs + r * 256 + ((chunk ^ (r & 15)) << 4));
          s[m] = MFMA32(kf, qf, s[m]); }
      __builtin_amdgcn_sched_barrier(0);
      bf16x8 pf[2][2];
#pragma unroll
      for (int m = 0; m < 2; ++m) {
        float mx = s[m][0];
#pragma unroll
        for (int i = 1; i < 16; ++i) mx = fmaxf(mx, s[m][i]);
        mx = fmaxf(mx, __shfl_xor(mx, 32));
        if (__any(mx > mrun[m] + 8.f)) {
          const float mn = fmaxf(mrun[m], mx); const float alpha = __builtin_amdgcn_exp2f(mrun[m] - mn); mrun[m] = mn; lsum[m] *= alpha;
#pragma unroll
          for (int et = 0; et < 4; ++et)
#pragma unroll
            for (int i = 0; i < 16; ++i) O[m][et][i] *= alpha;
        }
        float ps = 0.f; float pv[16];
#pragma unroll
        for (int i = 0; i < 16; ++i) { pv[i] = __builtin_amdgcn_exp2f(s[m][i] - mrun[m]); ps += pv[i]; }
        lsum[m] += ps;
#pragma unroll
        for (int s2 = 0; s2 < 2; ++s2) { u32x4 w; w.x = pack2(pv[8 * s2], pv[8 * s2 + 1]); w.y = pack2(pv[8 * s2 + 2], pv[8 * s2 + 3]); w.z = pack2(pv[8 * s2 + 4], pv[8 * s2 + 5]); w.w = pack2(pv[8 * s2 + 6], pv[8 * s2 + 7]);
          pf[m][s2] = __builtin_bit_cast(bf16x8, w); }
      }
      __builtin_amdgcn_sched_barrier(0);
#pragma unroll
      for (int s2 = 0; s2 < 2; ++s2) {
#pragma unroll
        for (int et = 0; et < 4; ++et) { const int vr = et * 32 + r; const int chunk = 2 * (sub * 2 + s2) + hh;
          const bf16x8 vf = *(const bf16x8*)(cur + 16384 + vr * 128 + ((chunk ^ ((vr >> 1) & 7)) << 4));
          O[0][et] = MFMA32(vf, pf[0][s2], O[0][et]); O[1][et] = MFMA32(vf, pf[1][s2], O[1][et]); }
      }
      __builtin_amdgcn_sched_barrier(0);
    }
    if (kt + 1 < nkt) st_tile(nxt);
    __syncthreads();
  }
  const float lam = lambda_full(p, lane);
  const float l1 = lsum[0] + __shfl_xor(lsum[0], 32), l2 = lsum[1] + __shfl_xor(lsum[1], 32);
  const float i1 = 1.f / l1, i2 = lam / l2;
  float ss = 0.f;
#pragma unroll
  for (int et = 0; et < 4; ++et)
#pragma unroll
    for (int i = 0; i < 16; ++i) { const float o = O[0][et][i] * i1 - O[1][et][i] * i2; O[0][et][i] = o; ss += o * o; }
  ss += __shfl_xor(ss, 32);
  const float rstd = rsqrtf(ss * (1.f / 128.f) + EPSF) * 0.8f;
#pragma unroll
  for (int et = 0; et < 4; ++et)
#pragma unroll
    for (int g = 0; g < 4; ++g) { const int e0 = et * 32 + 8 * g + 4 * hh;
      const f32x4 gs = *(const f32x4*)(p.g_subln + e0);
      const u32x2 ga = *(const u32x2*)(p.gatt + (size_t)tokq * 1024 + hd * 128 + e0);
      const float v0 = O[0][et][4 * g] * rstd * gs[0] * siluf(bflo(ga.x)), v1 = O[0][et][4 * g + 1] * rstd * gs[1] * siluf(bfhi(ga.x));
      const float v2 = O[0][et][4 * g + 2] * rstd * gs[2] * siluf(bflo(ga.y)), v3 = O[0][et][4 * g + 3] * rstd * gs[3] * siluf(bfhi(ga.y));
      u32x2 w; w.x = pack2(v0, v1); w.y = pack2(v2, v3);
      *(u32x2*)(p.gatt + (size_t)tokq * 1024 + hd * 128 + e0) = w; }
}

DI void phase4(const Params& p, int wv) {
  const int G = gridDim.x;
  for (int it = blockIdx.x; it < 512; it += G) {
    int b, hd, qb;
    if ((G & 7) == 0 && (512 % G) == 0) { const int x = blockIdx.x & 7, j = blockIdx.x >> 3, i = it / G; const int idx = i * (G >> 3) + j; hd = x; b = idx >> 4; qb = idx & 15; }
    else { b = it >> 7; hd = (it >> 4) & 7; qb = it & 15; }
    attn_item(p, false, b, hd, qb, wv);
  }
  for (int it = blockIdx.x; it < 128; it += G) attn_item(p, true, it >> 3, it & 7, 0, wv);
  for (int u = blockIdx.x; u < 1280; u += G) lru_unit<true>(p, u, wv);
}

DI void phase5(const Params& p, int wv) {
  TID_DECL const int wr = wave >> 2, wc = wave & 3, r = lane & 31, hh = lane >> 5;
  for (int u = blockIdx.x; u < 160 * 4; u += gridDim.x) {
    const int tm = u >> 2, tn = u & 3; const int m0 = tm * 128, n0 = tn * 256;
    f32x16 acc[2][2];
    gemm_tile<2>(p.gatt, p.glru, 1024, p.woutT, 2048, 2048, m0, n0, acc, wv);
#pragma unroll
    for (int mt = 0; mt < 2; ++mt)
#pragma unroll
      for (int nt = 0; nt < 2; ++nt)
#pragma unroll
        for (int reg = 0; reg < 16; ++reg) p.o2[(size_t)(m0 + wr * 64 + mt * 32 + crow(reg, hh)) * 1024 + n0 + wc * 64 + nt * 32 + r] = acc[mt][nt][reg];
  }
}

DI void phase6(const Params& p, int wv) {
  TID_DECL
  for (int u = blockIdx.x; u < NTOK / NWAVE; u += gridDim.x) {
    const int tok = u * NWAVE + wave; const float* x = xrow(p, tok); const float* md = p.mod + modidx(tok) * 3072 + 2048; const float* o = p.o2 + (size_t)tok * 1024;
    f32x4 ov[4]; float ss = 0.f;
#pragma unroll
    for (int i = 0; i < 4; ++i) { ov[i] = *(const f32x4*)(o + lane * 4 + 256 * i); ss += ov[i][0] * ov[i][0] + ov[i][1] * ov[i][1] + ov[i][2] * ov[i][2] + ov[i][3] * ov[i][3]; }
#pragma unroll
    for (int s = 32; s >= 1; s >>= 1) ss += __shfl_xor(ss, s);
    const float rstd = rsqrtf(ss * (1.f / 1024.f) + EPSF);
#pragma unroll
    for (int i = 0; i < 4; ++i) { const int col = lane * 4 + 256 * i;
      const f32x4 g = *(const f32x4*)(p.g_post + col), gt = *(const f32x4*)(md + col), xv = *(const f32x4*)(x + col);
      f32x4 y;
#pragma unroll
      for (int j = 0; j < 4; ++j) y[j] = xv[j] + gt[j] * (ov[i][j] * rstd * g[j]);
      *(f32x4*)(p.out + (size_t)tok * 1024 + col) = y; }
  }
}

#define XB_TMO      128
#define XB_XCNT(j)  (256  + 64 * (j))
#define XB_XSUB(j)  (1280 + 64 * (j))
#define XB_XGEN(j)  (2304 + 64 * (j))
#define XB_TOP      3328
#define XB_TOPGEN   3392
#define XCD_BAR_WORDS 3456
#define XB_SPIN_CAP (1u << 20)
__shared__ uint4 xb_words;
DI unsigned xb_ld(unsigned* p) { return __hip_atomic_load(p, __ATOMIC_RELAXED, __HIP_MEMORY_SCOPE_AGENT); }
DI unsigned xb_add(unsigned* p, unsigned v) { return __hip_atomic_fetch_add(p, v, __ATOMIC_RELAXED, __HIP_MEMORY_SCOPE_AGENT); }
DI unsigned xb_xcc_id() { return (unsigned)__builtin_amdgcn_s_getreg((3 << 11) | 20) & 0xFu; }
#define XB_SPIN(cond, bar) do { unsigned _sp = 0; while (cond) { __builtin_amdgcn_s_sleep(1); \
    if ((++_sp & 255u) == 0u) { if (xb_ld(&(bar)[XB_TMO])) break; if (_sp > XB_SPIN_CAP) { atomicAdd(&(bar)[XB_TMO], 1u); break; } } } } while (0)
DI void xcd_barrier_complete(unsigned* bar, unsigned x, unsigned& nloc, unsigned& nx) {
  const unsigned G = gridDim.x;
  unsigned sum, cnt, mine, sp = 0u;
  for (;;) {
    sum = 0u; cnt = 0u; mine = 0u;
#pragma unroll
    for (unsigned j = 0; j < 16; ++j) { const unsigned c = xb_ld(&bar[XB_XCNT(j)]); sum += c; cnt += (c > 0u) ? 1u : 0u; mine = (j == x) ? c : mine; }
    if (sum == G) break;
    __builtin_amdgcn_s_sleep(1);
    if ((++sp & 255u) == 0u) { if (xb_ld(&bar[XB_TMO])) break; if (sp > XB_SPIN_CAP) { atomicAdd(&bar[XB_TMO], 1u); break; } }
  }
  nloc = mine > 0u ? mine : 1u; nx = cnt > 0u ? cnt : 1u;
}
DI void grid_barrier(unsigned* bar, bool leader) {
  asm volatile("s_waitcnt vmcnt(0)" ::: "memory");
  __syncthreads();
  if (leader) {
    volatile unsigned* st = (volatile unsigned*)&xb_words;
    const unsigned x = xb_xcc_id();
    __builtin_amdgcn_s_waitcnt(0);
    unsigned nloc = st[0], nx = st[1];
    if (nloc == 0u) { xcd_barrier_complete(bar, x, nloc, nx); st[0] = nloc; st[1] = nx; }
    const unsigned old = xb_add(&bar[XB_XSUB(x)], 1u);
    const unsigned gen = old / nloc;
    if (old + 1u == (gen + 1u) * nloc) {
      __builtin_amdgcn_fence(__ATOMIC_RELEASE, "agent");
      asm volatile("s_waitcnt vmcnt(0)" ::: "memory");
      const unsigned og = xb_add(&bar[XB_TOP], 1u);
      const unsigned tg = og / nx;
      if (og + 1u == (tg + 1u) * nx) xb_add(&bar[XB_TOPGEN], 1u);
      else XB_SPIN(xb_ld(&bar[XB_TOPGEN]) == tg, bar);
      __builtin_amdgcn_fence(__ATOMIC_ACQUIRE, "agent");
      xb_add(&bar[XB_XGEN(x)], 1u);
      asm volatile("s_waitcnt vmcnt(0)" ::: "memory");
    } else {
      XB_SPIN(xb_ld(&bar[XB_XGEN(x)]) == gen, bar);
      __builtin_amdgcn_fence(__ATOMIC_ACQUIRE, "agent");
      asm volatile("s_waitcnt vmcnt(0)" ::: "memory");
    }
  }
  __syncthreads();
}

__global__ void __launch_bounds__(512) fwd_megakernel(Params p) {
  const int lo = p.phase_lo, hi = p.phase_hi;
  const int wv = __builtin_amdgcn_readfirstlane((int)(threadIdx.x >> 6));
  const bool leader = (wv == 0) && (lane_id() == 0);
  if (hi - lo > 1) {
    if (leader) { xb_words = make_uint4(0u, 0u, 0u, 0u); (void)xb_add(&p.bar[XB_XCNT(xb_xcc_id())], 1u); }
    __syncthreads();
  }
  if (lo <= 0 && hi > 0) phase0(p, wv);
  if (lo < 1 && hi > 1) grid_barrier(p.bar, leader);
  if (lo <= 1 && hi > 1) phase1(p, wv);
  if (lo < 2 && hi > 2) grid_barrier(p.bar, leader);
  if (lo <= 2 && hi > 2) phase2(p, wv);
  if (lo < 3 && hi > 3) grid_barrier(p.bar, leader);
  if (lo <= 3 && hi > 3) { for (int u = blockIdx.x; u < 1280; u += gridDim.x) lru_unit<false>(p, u, wv); }
  if (lo < 4 && hi > 4) grid_barrier(p.bar, leader);
  if (lo <= 4 && hi > 4) phase4(p, wv);
  if (lo < 5 && hi > 5) grid_barrier(p.bar, leader);
  if (lo <= 5 && hi > 5) phase5(p, wv);
  if (lo < 6 && hi > 6) grid_barrier(p.bar, leader);
  if (lo <= 6 && hi > 6) phase6(p, wv);
}

extern "C" void kernel_launch(void* const* d_in, const int* in_sizes, int n_in, void* d_out, int out_size, void* d_ws, size_t ws_size, hipStream_t stream) {
  static int grid_blocks = 0;
  if (!grid_blocks) {
    int dev = 0, cus = 0, per_cu = 0;
    (void)hipGetDevice(&dev);
    (void)hipDeviceGetAttribute(&cus, hipDeviceAttributeMultiprocessorCount, dev);
    (void)hipOccupancyMaxActiveBlocksPerMultiprocessor(&per_cu, fwd_megakernel, NTHR, 0);
    if (per_cu > 1) per_cu = 1;
    if (per_cu < 1) per_cu = 1;
    grid_blocks = cus * per_cu;
  }
  Params p{};
  const float** fp = (const float**)&p;
  for (int i = 0; i < 25; ++i) fp[i] = (const float*)d_in[i];
  p.out = (float*)d_out;
  char* w = (char*)d_ws; size_t off = 0;
  auto take = [&](size_t bytes) { char* r = w + off; off += (bytes + 255) & ~(size_t)255; return r; };
  p.mod = (float*)take(5 * 3072 * 4);
  p.winT = (bf16_t*)take((size_t)6144 * 1024 * 2);
  p.woutT = (bf16_t*)take((size_t)1024 * 2048 * 2);
  p.wgT = (bf16_t*)take((size_t)32 * 16384 * 2);
  p.h = (bf16_t*)d_out;
  p.q = p.h + (size_t)NTOK * 1024;
  p.Kc = (bf16_t*)take((size_t)4096 * 1024 * 2);
  p.Ks = (bf16_t*)take((size_t)4 * 4608 * 1024 * 2);
  p.Vtc = (bf16_t*)take((size_t)16 * 8 * 128 * 256 * 2);
  p.Vts = (bf16_t*)take((size_t)4 * 8 * 128 * 4608 * 2);
  p.gatt = (bf16_t*)take((size_t)NTOK * 1024 * 2);
  p.xlru = (bf16_t*)take((size_t)NTOK * 1024 * 2);
  p.glru = (bf16_t*)take((size_t)NTOK * 1024 * 2);
  p.agg = (float*)take((size_t)2 * 320 * 2048 * 4);
  p.o2 = (float*)d_out;
  p.bar = (unsigned*)take(XCD_BAR_WORDS * 4);
  if (off > ws_size) { fprintf(stderr, "workspace too small: need %zu have %zu\n", off, ws_size); return; }
#if MULTI_LAUNCH
  for (int ph = 0; ph < 7; ++ph) { p.phase_lo = ph; p.phase_hi = ph + 1; hipLaunchKernelGGL(fwd_megakernel, dim3(grid_blocks), dim3(NTHR), 0, stream, p); }
#else
  (void)hipMemsetAsync(p.bar, 0, XCD_BAR_WORDS * 4, stream);
  p.phase_lo = 0; p.phase_hi = 7;
  void* args[] = {&p};
  hipError_t e = hipLaunchCooperativeKernel((void*)fwd_megakernel, dim3(grid_blocks), dim3(NTHR), args, 0, stream);
  if (e != hipSuccess) fprintf(stderr, "cooperative launch failed: %s (grid %d)\n", hipGetErrorString(e), grid_blocks);
#endif
}
```

```cpp
#include <hip/hip_runtime.h>
#include <cstdio>
#include <cstdint>

#ifndef MULTI_LAUNCH
#define MULTI_LAUNCH 0
#endif

#define DI __device__ __forceinline__
typedef unsigned short bf16_t;
typedef short bf16x8 __attribute__((ext_vector_type(8)));
typedef float f32x16 __attribute__((ext_vector_type(16)));
typedef float f32x4 __attribute__((ext_vector_type(4)));
typedef float f32x2 __attribute__((ext_vector_type(2)));
typedef unsigned u32x4 __attribute__((ext_vector_type(4)));
typedef unsigned u32x2 __attribute__((ext_vector_type(2)));
typedef __bf16 bf16x2_t __attribute__((ext_vector_type(2)));
#define MFMA32(a, b, c) __builtin_amdgcn_mfma_f32_32x32x16_bf16((a), (b), (c), 0, 0, 0)

constexpr int NTOK = 20480, NCTX = 4096, NTHR = 512, NWAVE = 8;
constexpr float EPSF = 1e-6f;
constexpr int OUT_NK = 20971520, OUT_NV = 25165824, OUT_ST = 29360128;

struct Params {
  const float *x_prompt, *x_sample, *cache_k, *cache_v, *state_lru, *c, *c_ctx, *w_ada, *b_ada, *g_pre, *w_in;
  const float *lq1, *lk1, *lq2, *lk2, *g_subln, *conv_w, *conv_b, *w_rgate, *b_rgate, *w_igate, *b_igate, *lru_lambda, *w_out, *g_post;
  float* out;
  float* mod;
  bf16_t* winT;
  bf16_t* woutT;
  bf16_t* wgT;
  bf16_t* h;
  bf16_t* q;
  bf16_t* Kc;
  bf16_t* Ks;
  bf16_t* Vtc;
  bf16_t* Vts;
  bf16_t* gatt;
  bf16_t* xlru;
  bf16_t* glru;
  float* agg;
  float* carry;
  float* o2;
  unsigned* bar;
  int phase_lo, phase_hi;
};

DI int lane_id() { return (int)__builtin_amdgcn_mbcnt_hi(~0u, __builtin_amdgcn_mbcnt_lo(~0u, 0u)); }
#define TID_DECL int lane_v_ = lane_id(); asm volatile("" : "+v"(lane_v_)); const int lane = lane_v_; const int wave = wv; const int tid = wave * 64 + lane; (void)tid; (void)lane; (void)wave;
DI unsigned pack2(float lo, float hi) { f32x2 v = {lo, hi}; bf16x2_t b = __builtin_convertvector(v, bf16x2_t); return __builtin_bit_cast(unsigned, b); }
DI float bflo(unsigned u) { return __uint_as_float(u << 16); }
DI float bfhi(unsigned u) { return __uint_as_float(u & 0xffff0000u); }
DI float bf1(bf16_t h) { return __uint_as_float(((unsigned)h) << 16); }
DI bf16_t f2bf(float f) { return (bf16_t)(pack2(f, 0.f) & 0xffffu); }
DI float siluf(float x) { return x / (1.f + __expf(-x)); }
DI float sigm(float x) { return 1.f / (1.f + __expf(-x)); }
DI int crow(int reg, int hh) { return (reg & 3) + 8 * (reg >> 2) + 4 * hh; }
DI const float* xrow(const Params& p, int tok) { return tok < NCTX ? p.x_prompt + (size_t)tok * 1024 : p.x_sample + (size_t)(tok - NCTX) * 1024; }
DI int modidx(int tok) { return tok < NCTX ? 0 : 1 + ((tok - NCTX) >> 12); }

__shared__ __attribute__((aligned(16))) char lds[131072];

DI void transpose_tile(const float* src, size_t sld, bf16_t* dst, size_t dld, int r0, int c0, float* sm, int wv) {
  const int lx = lane_id(), ly = wv;
#pragma unroll
  for (int i = 0; i < 8; ++i) { const int r = ly + 8 * i; sm[r * 65 + lx] = src[(size_t)(r0 + r) * sld + c0 + lx]; }
  __syncthreads();
  const int rp = lx & 31, cs = lx >> 5;
#pragma unroll
  for (int i = 0; i < 4; ++i) { const int cc = cs + 2 * ly + 16 * i;
    *(unsigned*)(dst + (size_t)(c0 + cc) * dld + r0 + 2 * rp) = pack2(sm[(2 * rp) * 65 + cc], sm[(2 * rp + 1) * 65 + cc]); }
  __syncthreads();
}

DI void mod_unit(const Params& p, int u, int wv) {
  float* sc = (float*)lds;
  float* red = sc + 5120;
  TID_DECL
  for (int i = tid; i < 5120; i += NTHR) { const int mi = i >> 10, k = i & 1023; const float cv = (mi == 0) ? p.c_ctx[k] : p.c[(mi - 1) * 1024 + k]; sc[i] = siluf(cv); }
  __syncthreads();
  const int col = tid & 31, kg = tid >> 5, n = u * 32 + col;
  float a0 = 0.f, a1 = 0.f, a2 = 0.f, a3 = 0.f, a4 = 0.f;
#pragma unroll 8
  for (int k = kg * 64; k < kg * 64 + 64; ++k) {
    const float w = p.w_ada[(size_t)k * 3072 + n];
    a0 += sc[k] * w; a1 += sc[1024 + k] * w; a2 += sc[2048 + k] * w; a3 += sc[3072 + k] * w; a4 += sc[4096 + k] * w;
  }
  red[(kg * 5 + 0) * 32 + col] = a0; red[(kg * 5 + 1) * 32 + col] = a1; red[(kg * 5 + 2) * 32 + col] = a2; red[(kg * 5 + 3) * 32 + col] = a3; red[(kg * 5 + 4) * 32 + col] = a4;
  __syncthreads();
  if (tid < 160) { const int mi = tid >> 5, cc = tid & 31; float s = p.b_ada[u * 32 + cc];
#pragma unroll
    for (int g = 0; g < 16; ++g) s += red[(g * 5 + mi) * 32 + cc];
    p.mod[mi * 3072 + u * 32 + cc] = s; }
  __syncthreads();
}

DI void phase0(const Params& p, int wv) {
  constexpr int NU_MOD = 96, NU_WIN = 1536, NU_WOUT = 512, NU_G = 128, NU_CV = 512, NU_CK = 512;
  constexpr int TOTAL = NU_MOD + NU_WIN + NU_WOUT + NU_G + NU_CV + NU_CK;
  float* sm = (float*)lds;
  for (int u = blockIdx.x; u < TOTAL; u += gridDim.x) {
    int v = u;
    if (v < NU_MOD) { mod_unit(p, v, wv); continue; } v -= NU_MOD;
    if (v < NU_WIN) { const int tr = v / 96, tc = v % 96; transpose_tile(p.w_in, 6144, p.winT, 1024, tr * 64, tc * 64, sm, wv); continue; } v -= NU_WIN;
    if (v < NU_WOUT) { const int tr = v / 16, tc = v % 16; transpose_tile(p.w_out, 1024, p.woutT, 2048, tr * 64, tc * 64, sm, wv); continue; } v -= NU_WOUT;
    if (v < NU_G) { const int mtx = v >> 2, t = v & 3; const int dir = mtx >> 4, gate = (mtx >> 3) & 1, blk = mtx & 7;
      const float* src = (gate ? p.w_igate : p.w_rgate) + (size_t)(dir * 8 + blk) * 16384;
      transpose_tile(src, 128, p.wgT + (size_t)mtx * 16384, 128, (t >> 1) * 64, (t & 1) * 64, sm, wv); continue; } v -= NU_G;
    if (v < NU_CV) { const int bh = v >> 4, t = v & 15; const int b = bh >> 3, hd = bh & 7;
      const float* src = p.cache_v + (size_t)b * 512 * 1024 + hd * 128;
      transpose_tile(src, 1024, p.Vts + (size_t)bh * 128 * 4608, 4608, (t >> 1) * 64, (t & 1) * 64, sm, wv); continue; } v -= NU_CV;
    { const size_t i0 = (size_t)v * 4096 + (wv * 64 + lane_id()) * 8; const size_t b = i0 / (512 * 1024), rem = i0 % (512 * 1024);
      const f32x4 x0 = *(const f32x4*)(p.cache_k + i0), x1 = *(const f32x4*)(p.cache_k + i0 + 4);
      u32x4 w; w.x = pack2(x0[0], x0[1]); w.y = pack2(x0[2], x0[3]); w.z = pack2(x1[0], x1[1]); w.w = pack2(x1[2], x1[3]);
      *(u32x4*)(p.Ks + b * (size_t)4608 * 1024 + rem) = w; }
  }
}

DI void phase1(const Params& p, int wv) {
  TID_DECL
  for (int u = blockIdx.x; u < NTOK / NWAVE; u += gridDim.x) {
    const int tok = u * NWAVE + wave; const float* x = xrow(p, tok); const float* md = p.mod + modidx(tok) * 3072;
    f32x4 xv[4]; float ss = 0.f;
#pragma unroll
    for (int i = 0; i < 4; ++i) { xv[i] = *(const f32x4*)(x + lane * 4 + 256 * i); ss += xv[i][0] * xv[i][0] + xv[i][1] * xv[i][1] + xv[i][2] * xv[i][2] + xv[i][3] * xv[i][3]; }
#pragma unroll
    for (int o = 32; o >= 1; o >>= 1) ss += __shfl_xor(ss, o);
    const float rstd = rsqrtf(ss * (1.f / 1024.f) + EPSF);
#pragma unroll
    for (int i = 0; i < 4; ++i) { const int col = lane * 4 + 256 * i;
      const f32x4 g = *(const f32x4*)(p.g_pre + col), sh = *(const f32x4*)(md + col), scl = *(const f32x4*)(md + 1024 + col);
      float o[4];
#pragma unroll
      for (int j = 0; j < 4; ++j) o[j] = xv[i][j] * rstd * g[j] * (1.f + scl[j]) + sh[j];
      u32x2 w; w.x = pack2(o[0], o[1]); w.y = pack2(o[2], o[3]);
      *(u32x2*)(p.h + (size_t)tok * 1024 + col) = w; }
  }
}

template <int MT> struct GemmRegs { u32x4 a[MT], b[4]; };
template <int MT>
DI void g_load(const bf16_t* A, int lda, const bf16_t* Bt, int ldb, int m0, int n0, int k0, GemmRegs<MT>& g, int tid) {
  const unsigned offa = (unsigned)(((tid >> 3) * lda + (tid & 7) * 8) * 2), offb = (unsigned)(((tid >> 3) * ldb + (tid & 7) * 8) * 2);
  const char* Ab = (const char*)(A + (size_t)m0 * lda + (k0 & 1023));
  const char* Bb = (const char*)(Bt + (size_t)n0 * ldb + k0);
#pragma unroll
  for (int i = 0; i < MT; ++i) g.a[i] = *(const u32x4*)(Ab + (size_t)i * 64 * lda * 2 + offa);
#pragma unroll
  for (int i = 0; i < 4; ++i) g.b[i] = *(const u32x4*)(Bb + (size_t)i * 64 * ldb * 2 + offb);
}
template <int MT>
DI void g_store(char* buf, const GemmRegs<MT>& g, int tid) {
#pragma unroll
  for (int i = 0; i < MT; ++i) { const int id = tid + NTHR * i, row = id >> 3, ch = id & 7; *(u32x4*)(buf + row * 128 + ((ch ^ ((row >> 1) & 7)) << 4)) = g.a[i]; }
#pragma unroll
  for (int i = 0; i < 4; ++i) { const int id = tid + NTHR * i, row = id >> 3, ch = id & 7; *(u32x4*)(buf + MT * 8192 + row * 128 + ((ch ^ ((row >> 1) & 7)) << 4)) = g.b[i]; }
}
template <int MT>
DI void g_compute(const char* buf, f32x16 (&acc)[MT][2], int wr, int wc, int lane) {
  const int r = lane & 31, hh = lane >> 5;
#pragma unroll
  for (int ks = 0; ks < 4; ++ks) { const int chunk = 2 * ks + hh; bf16x8 af[MT], bg[2];
#pragma unroll
    for (int mt = 0; mt < MT; ++mt) { const int row = wr * (32 * MT) + mt * 32 + r; af[mt] = *(const bf16x8*)(buf + row * 128 + ((chunk ^ ((row >> 1) & 7)) << 4)); }
#pragma unroll
    for (int nt = 0; nt < 2; ++nt) { const int row = wc * 64 + nt * 32 + r; bg[nt] = *(const bf16x8*)(buf + MT * 8192 + row * 128 + ((chunk ^ ((row >> 1) & 7)) << 4)); }
#pragma unroll
    for (int mt = 0; mt < MT; ++mt)
#pragma unroll
      for (int nt = 0; nt < 2; ++nt) acc[mt][nt] = MFMA32(af[mt], bg[nt], acc[mt][nt]);
  }
}
template <int MT>
DI void gemm_tile(const bf16_t* A, const bf16_t* A2, int lda, const bf16_t* Bt, int ldb, int K, int m0, int n0, f32x16 (&acc)[MT][2], int wv) {
  TID_DECL const int wr = wave >> 2, wc = wave & 3;
  constexpr int STAGE = MT * 8192 + 32768;
  GemmRegs<MT> gA, gB; const int nk = K >> 6;
  auto ldk = [&](int kt, GemmRegs<MT>& g) { const int kc = kt < nk ? kt : nk - 1; g_load<MT>(kc < 16 ? A : A2, lda, Bt, ldb, m0, n0, kc << 6, g, tid); };
  ldk(0, gA); g_store<MT>(lds, gA, tid); ldk(1, gA); ldk(2, gB); __syncthreads();
  __builtin_amdgcn_sched_barrier(0);
#pragma unroll
  for (int mt = 0; mt < MT; ++mt)
#pragma unroll
    for (int nt = 0; nt < 2; ++nt)
#pragma unroll
      for (int i = 0; i < 16; ++i) acc[mt][nt][i] = 0.f;
  for (int kt = 0; kt < nk; kt += 2) {
    g_compute<MT>(lds, acc, wr, wc, lane);
    g_store<MT>(lds + STAGE, gA, tid);
    ldk(kt + 3, gA);
    __syncthreads();
    g_compute<MT>(lds + STAGE, acc, wr, wc, lane);
    if (kt + 2 < nk) g_store<MT>(lds, gB, tid);
    ldk(kt + 4, gB);
    __syncthreads();
  }
}

DI void phase2(const Params& p, int wv) {
  TID_DECL const int wr = wave >> 2, wc = wave & 3, r = lane & 31, hh = lane >> 5;
  constexpr int NT_N = 24, NT_M = 80;
  const bool xmap = gridDim.x == 256;
  for (int i = 0; i < (xmap ? 8 : (NT_N * NT_M + (int)gridDim.x - 1) / (int)gridDim.x); ++i) {
    const int u = blockIdx.x + i * gridDim.x;
    int tm, tn;
    if (xmap) { const int x = blockIdx.x & 7, j = blockIdx.x >> 3, s = i * 8 + x; if (s >= 60) break; tm = (s / 3) * 4 + (j >> 3); tn = (s % 3) * 8 + (j & 7); }
    else { if (u >= NT_N * NT_M) break; tm = u / NT_N; tn = u % NT_N; }
    const int m0 = tm * 256, n0 = tn * 256;
    f32x16 acc[4][2];
    gemm_tile<4>(p.h, p.h, 1024, p.winT, 1024, 1024, m0, n0, acc, wv);
    const int ctype = n0 >> 10; const bool ctx = m0 < NCTX;
    const int b = ctx ? (m0 >> 8) : ((m0 - NCTX) >> 12);
    int hh_o = hh; asm volatile("" : "+v"(hh_o));
#pragma unroll
    for (int mt = 0; mt < 4; ++mt) {
      const int rowbase = m0 + wr * 128 + mt * 32;
      const int tseq = ctx ? (rowbase & 255) : ((rowbase - NCTX) & 4095);
#pragma unroll
      for (int nt = 0; nt < 2; ++nt) {
        __builtin_amdgcn_sched_barrier(0);
        const int cin = (n0 & 1023) + wc * 64 + nt * 32 + r;
        f32x16 v = acc[mt][nt];
        if (ctype <= 1) {
          if (!ctx) {
            const int i = (lane & 15) + (hh_o & 0); const bool second = (lane & 16) != 0;
            const float inv = __builtin_amdgcn_exp2f(-(float)i * 0.8304820237218405f);
#pragma unroll
            for (int reg = 0; reg < 16; ++reg) {
              const int t = tseq + crow(reg, hh_o);
              const float pos = (nt & 1) ? (float)(t & 63) : (float)(t >> 6);
              const float ang = pos * inv; const float sn = __sinf(ang), cs = __cosf(ang);
              const float x = v[reg]; const float xp = __shfl_xor(x, 16);
              v[reg] = second ? (xp * sn + x * cs) : (x * cs - xp * sn);
            }
          }
          if (ctype == 0) {
#pragma unroll
            for (int reg = 0; reg < 16; ++reg) p.q[(size_t)(rowbase + crow(reg, hh)) * 1024 + cin] = f2bf(v[reg] * 0.18033688011112042f);
          } else {
#pragma unroll
            for (int reg = 0; reg < 16; ++reg) { const int tok = rowbase + crow(reg, hh);
              if (ctx) { p.Kc[(size_t)tok * 1024 + cin] = f2bf(v[reg]); p.out[OUT_NK + (size_t)tok * 1024 + cin] = v[reg]; }
              else { const int t = tseq + crow(reg, hh); p.Ks[((size_t)b * 4608 + 512 + t) * 1024 + cin] = f2bf(v[reg]); } }
          }
        } else if (ctype == 2) {
          const int hd = cin >> 7, e = cin & 127;
          bf16_t* vt = ctx ? p.Vtc + ((size_t)(b * 8 + hd) * 128 + e) * 256 + tseq : p.Vts + ((size_t)(b * 8 + hd) * 128 + e) * 4608 + 512 + tseq;
#pragma unroll
          for (int g = 0; g < 4; ++g) { u32x2 w; w.x = pack2(v[4 * g], v[4 * g + 1]); w.y = pack2(v[4 * g + 2], v[4 * g + 3]); *(u32x2*)(vt + 8 * g + 4 * hh) = w; }
          if (ctx) {
#pragma unroll
            for (int reg = 0; reg < 16; ++reg) p.out[OUT_NV + (size_t)(rowbase + crow(reg, hh)) * 1024 + cin] = v[reg];
          }
        } else {
          bf16_t* dst = (ctype == 3) ? p.gatt : (ctype == 4) ? p.xlru : p.glru;
#pragma unroll
          for (int reg = 0; reg < 16; ++reg) dst[(size_t)(rowbase + crow(reg, hh)) * 1024 + cin] = f2bf(v[reg]);
        }
      }
    }
  }
}

DI float softplusf(float x) { return x > 20.f ? x : log1pf(__expf(x)); }
template <bool PASS2>
DI void lru_unit(const Params& p, int unit, int wv) {
  TID_DECL const int r = lane & 31, hh = lane >> 5;
  const int c2 = unit >> 3, blk = unit & 7; const int tok0 = c2 * 128, ch0 = blk * 128;
  const bool ctx = tok0 < NCTX;
  const int seq_start = ctx ? (tok0 & ~255) : (NCTX + ((tok0 - NCTX) & ~4095)); const int seq_len = ctx ? 256 : 4096;
  const int b = ctx ? (tok0 >> 8) : ((tok0 - NCTX) >> 12);
  char* sU = lds;
  float* sS = (float*)(lds + 32768);
  { const int cc = tid & 15, tg = tid >> 4; const int c8 = ch0 + cc * 8;
    float xin[7][8];
#pragma unroll
    for (int j = 0; j < 7; ++j) { const int tok = tok0 + tg * 4 - 1 + j; const bool ok = tok >= seq_start && tok < seq_start + seq_len;
      u32x4 w = {0u, 0u, 0u, 0u}; if (ok) w = *(const u32x4*)(p.xlru + (size_t)tok * 1024 + c8);
      xin[j][0] = bflo(w.x); xin[j][1] = bfhi(w.x); xin[j][2] = bflo(w.y); xin[j][3] = bfhi(w.y); xin[j][4] = bflo(w.z); xin[j][5] = bfhi(w.z); xin[j][6] = bflo(w.w); xin[j][7] = bfhi(w.w); }
    float cw[4][8], cb[8];
#pragma unroll
    for (int j = 0; j < 4; ++j) { const f32x4 w0 = *(const f32x4*)(p.conv_w + j * 1024 + c8), w1 = *(const f32x4*)(p.conv_w + j * 1024 + c8 + 4);
      cw[j][0] = w0[0]; cw[j][1] = w0[1]; cw[j][2] = w0[2]; cw[j][3] = w0[3]; cw[j][4] = w1[0]; cw[j][5] = w1[1]; cw[j][6] = w1[2]; cw[j][7] = w1[3]; }
    { const f32x4 b0 = *(const f32x4*)(p.conv_b + c8), b1 = *(const f32x4*)(p.conv_b + c8 + 4); cb[0] = b0[0]; cb[1] = b0[1]; cb[2] = b0[2]; cb[3] = b0[3]; cb[4] = b1[0]; cb[5] = b1[1]; cb[6] = b1[2]; cb[7] = b1[3]; }
#pragma unroll
    for (int t = 0; t < 4; ++t) { float uu[8];
#pragma unroll
      for (int e = 0; e < 8; ++e) uu[e] = cb[e] + cw[0][e] * xin[t][e] + cw[1][e] * xin[t + 1][e] + cw[2][e] * xin[t + 2][e] + cw[3][e] * xin[t + 3][e];
      u32x4 w; w.x = pack2(uu[0], uu[1]); w.y = pack2(uu[2], uu[3]); w.z = pack2(uu[4], uu[5]); w.w = pack2(uu[6], uu[7]);
      const int row = tg * 4 + t; *(u32x4*)(sU + row * 256 + ((cc ^ (row & 15)) << 4)) = w; }
  }
  __syncthreads();
  const int cg = wave & 3, th = wave >> 2;
  const int chl = cg * 32 + r, ch = ch0 + chl;
  const int chunk = c2 * 2 + th;
  const int cfirst = seq_start >> 6, clast = (seq_start + seq_len - 64) >> 6;
  float hf[2][16];
#pragma unroll
  for (int dir = 0; dir < 2; ++dir) {
    __builtin_amdgcn_sched_barrier(0);
    f32x16 acc[2][2];
#pragma unroll
    for (int g = 0; g < 2; ++g)
#pragma unroll
      for (int mt = 0; mt < 2; ++mt)
#pragma unroll
        for (int i = 0; i < 16; ++i) acc[g][mt][i] = 0.f;
    const bf16_t* wr_ = p.wgT + ((size_t)((dir * 2 + 0) * 8 + blk) * 128 + chl) * 128;
    const bf16_t* wi_ = p.wgT + ((size_t)((dir * 2 + 1) * 8 + blk) * 128 + chl) * 128;
#pragma unroll
    for (int ks = 0; ks < 8; ++ks) { const int chunkk = 2 * ks + hh;
      const bf16x8 br = *(const bf16x8*)(wr_ + chunkk * 8), bi = *(const bf16x8*)(wi_ + chunkk * 8);
      bf16x8 af[2];
#pragma unroll
      for (int mt = 0; mt < 2; ++mt) { const int row = th * 64 + mt * 32 + r; af[mt] = *(const bf16x8*)(sU + row * 256 + ((chunkk ^ (row & 15)) << 4)); }
#pragma unroll
      for (int mt = 0; mt < 2; ++mt) { acc[0][mt] = MFMA32(af[mt], br, acc[0][mt]); acc[1][mt] = MFMA32(af[mt], bi, acc[1][mt]); }
    }
    __builtin_amdgcn_sched_barrier(0);
    const float brg = p.b_rgate[dir * 1024 + ch], big = p.b_igate[dir * 1024 + ch];
    const float sp8 = -8.f * softplusf(-p.lru_lambda[dir * 1024 + ch]);
#pragma unroll
    for (int mt = 0; mt < 2; ++mt)
#pragma unroll
      for (int reg = 0; reg < 16; ++reg) { const int row = th * 64 + mt * 32 + crow(reg, hh);
        const float rg = sigm(acc[0][mt][reg] + brg), ig = sigm(acc[1][mt][reg] + big);
        const float a = __expf(sp8 * rg);
        const float om = (1.f - a) * (1.f + a);
        const float uv = bf1(*(const bf16_t*)(sU + row * 256 + (((chl >> 3) ^ (row & 15)) << 4) + (chl & 7) * 2));
        acc[0][mt][reg] = a; acc[1][mt][reg] = sqrtf(om) * ig * uv; }
    __builtin_amdgcn_sched_barrier(0);
    float GA[8], GB[8], OA[8], OB[8];
#pragma unroll
    for (int mt = 0; mt < 2; ++mt)
#pragma unroll
      for (int g = 0; g < 4; ++g) { const int i = mt * 4 + g;
        const float a0 = acc[0][mt][4 * g], a1 = acc[0][mt][4 * g + 1], a2 = acc[0][mt][4 * g + 2], a3 = acc[0][mt][4 * g + 3];
        const float b0 = acc[1][mt][4 * g], b1 = acc[1][mt][4 * g + 1], b2 = acc[1][mt][4 * g + 2], b3 = acc[1][mt][4 * g + 3];
        GA[i] = (a0 * a1) * (a2 * a3);
        GB[i] = (dir == 0) ? ((b0 * a1 + b1) * a2 + b2) * a3 + b3 : ((b3 * a2 + b2) * a1 + b1) * a0 + b0;
        OA[i] = __shfl_xor(GA[i], 32); OB[i] = __shfl_xor(GB[i], 32); }
    const bool mefirst = (dir == 0) ? (hh == 0) : (hh == 1);
    float hcar = 0.f;
    if (PASS2) hcar = p.carry[((size_t)dir * 320 + chunk) * 1024 + ch];
    float cin_[8]; float ap = 1.f; float cur = hcar;
#pragma unroll
    for (int ii = 0; ii < 8; ++ii) { const int i = (dir == 0) ? ii : 7 - ii;
      const float fA = mefirst ? GA[i] : OA[i], fB = mefirst ? GB[i] : OB[i], sA_ = mefirst ? OA[i] : GA[i], sB_ = mefirst ? OB[i] : GB[i];
      cin_[i] = mefirst ? cur : (fA * cur + fB);
      cur = sA_ * (fA * cur + fB) + sB_; ap *= fA * sA_; }
    if (!PASS2) { if (hh == 0) { float* ag = p.agg + ((size_t)dir * 320 + chunk) * 2048 + ch; ag[0] = ap; ag[1024] = cur; } }
    else {
#pragma unroll
      for (int mt = 0; mt < 2; ++mt)
#pragma unroll
        for (int g = 0; g < 4; ++g) { const int i = mt * 4 + g; float hv = cin_[i];
          if (dir == 0) {
#pragma unroll
            for (int j = 0; j < 4; ++j) { hv = acc[0][mt][4 * g + j] * hv + acc[1][mt][4 * g + j]; hf[mt][4 * g + j] = hv; }
          } else {
#pragma unroll
            for (int j = 3; j >= 0; --j) { hv = acc[0][mt][4 * g + j] * hv + acc[1][mt][4 * g + j]; hf[mt][4 * g + j] += hv; }
            if (ctx && chunk == cfirst && mt == 0 && g == 0 && hh == 0) p.out[OUT_ST + (size_t)b * 2048 + 1024 + ch] = hv;
          }
        }
      if (dir == 0 && ctx && chunk == clast && hh == 1) p.out[OUT_ST + (size_t)b * 2048 + ch] = hf[1][15];
    }
  }
  if (PASS2) {
#pragma unroll
    for (int mt = 0; mt < 2; ++mt)
#pragma unroll
      for (int reg = 0; reg < 16; ++reg) sS[(th * 64 + mt * 32 + crow(reg, hh)) * 128 + chl] = hf[mt][reg];
    __syncthreads();
    const int cc = tid & 15, tg = tid >> 4;
#pragma unroll
    for (int t = 0; t < 4; ++t) { const int row = tg * 4 + t; const int tok = tok0 + row;
      const f32x4 s0 = *(const f32x4*)(sS + row * 128 + cc * 8), s1 = *(const f32x4*)(sS + row * 128 + cc * 8 + 4);
      const u32x4 gw = *(const u32x4*)(p.glru + (size_t)tok * 1024 + ch0 + cc * 8);
      u32x4 w;
      w.x = pack2(s0[0] * siluf(bflo(gw.x)), s0[1] * siluf(bfhi(gw.x))); w.y = pack2(s0[2] * siluf(bflo(gw.y)), s0[3] * siluf(bfhi(gw.y)));
      w.z = pack2(s1[0] * siluf(bflo(gw.z)), s1[1] * siluf(bfhi(gw.z))); w.w = pack2(s1[2] * siluf(bflo(gw.w)), s1[3] * siluf(bfhi(gw.w)));
      *(u32x4*)(p.glru + (size_t)tok * 1024 + ch0 + cc * 8) = w; }
  }
  __syncthreads();
}

DI void phase_carry(const Params& p, int wv) {
  TID_DECL
  const int g = blockIdx.x * NTHR + tid;
  if (g >= 40960) return;
  const int ch = g & 1023, sq = (g >> 10) % 20, dir = g / 20480;
  const bool ctx = sq < 16;
  const int cfirst = ctx ? sq * 4 : 64 + (sq - 16) * 64, n = ctx ? 4 : 64;
  float h = ctx ? 0.f : p.state_lru[(size_t)(sq - 16) * 2048 + dir * 1024 + ch];
  const float* ag = p.agg + (size_t)dir * 320 * 2048 + ch; float* cy = p.carry + (size_t)dir * 320 * 1024 + ch;
  if (dir == 0) {
#pragma unroll 8
    for (int j = 0; j < n; ++j) { const int c = cfirst + j; const float a = ag[(size_t)c * 2048], b = ag[(size_t)c * 2048 + 1024]; cy[(size_t)c * 1024] = h; h = a * h + b; }
  } else {
#pragma unroll 8
    for (int j = n - 1; j >= 0; --j) { const int c = cfirst + j; const float a = ag[(size_t)c * 2048], b = ag[(size_t)c * 2048 + 1024]; cy[(size_t)c * 1024] = h; h = a * h + b; }
  }
}

DI float lambda_full(const Params& p, int lane) {
  float a = p.lq1[lane] * p.lk1[lane], c = p.lq2[lane] * p.lk2[lane];
#pragma unroll
  for (int o = 32; o >= 1; o >>= 1) { a += __shfl_xor(a, o); c += __shfl_xor(c, o); }
  return __expf(a) - __expf(c) + 0.2f;
}
DI int kperm(int r) { return (r & ~12) | ((r & 4) << 1) | ((r & 8) >> 1); }

typedef unsigned u32x2v __attribute__((ext_vector_type(2)));
DI float xmax32(float x) { const u32x2v t = __builtin_amdgcn_permlane32_swap(__float_as_uint(x), __float_as_uint(x), false, false); return fmaxf(__uint_as_float(t.x), __uint_as_float(t.y)); }
DI float max3f(float a, float b, float c) { float r_; asm("v_max3_f32 %0, %1, %2, %3" : "=v"(r_) : "v"(a), "v"(b), "v"(c)); return r_; }
DI float xsum32(float x) { const u32x2v t = __builtin_amdgcn_permlane32_swap(__float_as_uint(x), __float_as_uint(x), false, false); return __uint_as_float(t.x) + __uint_as_float(t.y); }

DI void attn_item(const Params& p, bool ctx, int b, int hd, int qb, int wv) {
  TID_DECL const int r = lane & 31, hh = lane >> 5;
  const int rg = wave >> 1, m = wave & 1;
  const int Tk = ctx ? 256 : 4608;
  const bf16_t* Kb = (ctx ? p.Kc + (size_t)b * 256 * 1024 : p.Ks + (size_t)b * 4608 * 1024) + hd * 128;
  const bf16_t* Vb = ctx ? p.Vtc + (size_t)(b * 8 + hd) * 128 * 256 : p.Vts + (size_t)(b * 8 + hd) * 128 * 4608;
  const int tokq = (ctx ? b * 256 : NCTX + b * 4096) + qb * 128 + rg * 32 + r;
  bf16x8 qf[4];
#pragma unroll
  for (int ks = 0; ks < 4; ++ks) qf[ks] = *(const bf16x8*)(p.q + (size_t)tokq * 1024 + hd * 128 + m * 64 + ks * 16 + hh * 8);
  f32x16 O[4];
#pragma unroll
  for (int et = 0; et < 4; ++et)
#pragma unroll
    for (int i = 0; i < 16; ++i) O[et][i] = 0.f;
  float mrun, lsum = 0.f;
  const int krow0 = tid >> 4, kch = tid & 15;
  const int vrow0 = tid >> 3, vch = tid & 7;
  struct Stg { u32x4 k[2], v[2]; };
  auto ld_tile = [&](int kt, Stg& g) {
#pragma unroll
    for (int i = 0; i < 2; ++i) {
      g.k[i] = *(const u32x4*)(Kb + (size_t)(kt * 64 + krow0 + 32 * i) * 1024 + kch * 8);
      g.v[i] = *(const u32x4*)(Vb + (size_t)(vrow0 + 64 * i) * Tk + kt * 64 + vch * 8); }
  };
  auto st_tile = [&](char* buf, const Stg& g) {
#pragma unroll
    for (int i = 0; i < 2; ++i) { const int kr_ = krow0 + 32 * i; *(u32x4*)(buf + kr_ * 256 + ((kch ^ (kr_ & 15)) << 4)) = g.k[i];
      const int vr = vrow0 + 64 * i; *(u32x4*)(buf + 16384 + vr * 128 + ((vch ^ ((vr >> 1) & 7)) << 4)) = g.v[i]; }
  };
  const int kr = kperm(r);
#define SB_MEM ((void)0)
  auto compute_S = [&](const char* buf, f32x16 (&s)[2]) {
    bf16x8 kf[2][4];
#pragma unroll
    for (int sub = 0; sub < 2; ++sub) { const int krow = sub * 32 + kr;
#pragma unroll
      for (int ks = 0; ks < 4; ++ks) { const int chunk = m * 8 + 2 * ks + hh; kf[sub][ks] = *(const bf16x8*)(buf + krow * 256 + ((chunk ^ (krow & 15)) << 4)); } }
    SB_MEM;
#pragma unroll
    for (int sub = 0; sub < 2; ++sub)
#pragma unroll
      for (int i = 0; i < 16; ++i) s[sub][i] = 0.f;
#pragma unroll
    for (int ks = 0; ks < 4; ++ks)
#pragma unroll
      for (int sub = 0; sub < 2; ++sub) s[sub] = MFMA32(kf[sub][ks], qf[ks], s[sub]);
    SB_MEM;
  };
  auto rowmax = [&](const f32x16 (&s)[2]) {
    float mx = max3f(s[0][0], s[0][1], s[0][2]);
#pragma unroll
    for (int i = 3; i < 15; i += 2) mx = max3f(mx, s[0][i], s[0][i + 1]);
    mx = max3f(mx, s[0][15], s[1][0]);
#pragma unroll
    for (int i = 1; i < 15; i += 2) mx = max3f(mx, s[1][i], s[1][i + 1]);
    mx = fmaxf(mx, s[1][15]);
    return xmax32(mx);
  };
  auto softmax_pv = [&](const char* buf, const f32x16 (&s)[2]) {
    bf16x8 pf[4]; float ps = 0.f;
#pragma unroll
    for (int sub = 0; sub < 2; ++sub) { float pv[16];
#pragma unroll
      for (int i = 0; i < 16; ++i) { pv[i] = __builtin_amdgcn_exp2f(s[sub][i] - mrun); ps += pv[i]; }
#pragma unroll
      for (int s2 = 0; s2 < 2; ++s2) { u32x4 w; w.x = pack2(pv[8 * s2], pv[8 * s2 + 1]); w.y = pack2(pv[8 * s2 + 2], pv[8 * s2 + 3]); w.z = pack2(pv[8 * s2 + 4], pv[8 * s2 + 5]); w.w = pack2(pv[8 * s2 + 6], pv[8 * s2 + 7]);
        pf[sub * 2 + s2] = __builtin_bit_cast(bf16x8, w); }
    }
    lsum += ps;
    bf16x8 vf[2][4];
#pragma unroll
    for (int et = 0; et < 4; ++et) { const int vr = et * 32 + r; vf[0][et] = *(const bf16x8*)(buf + 16384 + vr * 128 + (((hh) ^ ((vr >> 1) & 7)) << 4)); }
    SB_MEM;
#pragma unroll
    for (int s4 = 0; s4 < 4; ++s4) {
      if (s4 < 3) {
#pragma unroll
        for (int et = 0; et < 4; ++et) { const int vr = et * 32 + r; const int chunk = 2 * (s4 + 1) + hh; vf[(s4 + 1) & 1][et] = *(const bf16x8*)(buf + 16384 + vr * 128 + ((chunk ^ ((vr >> 1) & 7)) << 4)); }
      }
      SB_MEM;
#pragma unroll
      for (int et = 0; et < 4; ++et) O[et] = MFMA32(vf[s4 & 1][et], pf[s4], O[et]);
      SB_MEM;
    }
  };
  const int nkt = Tk >> 6;
  Stg gA, gB;
  ld_tile(0, gA); ld_tile(1, gB); st_tile(lds, gA); st_tile(lds + 32768, gB);
  ld_tile(2, gA); ld_tile(3, gB);
  __syncthreads();
  f32x16 sc[2];
  compute_S(lds, sc);
  mrun = rowmax(sc);
  int o0 = 0, o1 = 32768, o2 = 65536;
  auto step = [&](int kt, Stg& g) {
    f32x16 sn[2];
    compute_S(lds + o1, sn);
    softmax_pv(lds + o0, sc);
    const float mx = rowmax(sn);
    if (__any(mx > mrun + 8.f)) {
      asm volatile("" ::: "memory");
      const float mn = fmaxf(mrun, mx); const float alpha = __builtin_amdgcn_exp2f(mrun - mn); mrun = mn; lsum *= alpha;
#pragma unroll
      for (int et = 0; et < 4; ++et)
#pragma unroll
        for (int i = 0; i < 16; ++i) O[et][i] *= alpha;
    }
#pragma unroll
    for (int sub = 0; sub < 2; ++sub) sc[sub] = sn[sub];
    st_tile(lds + o2, g);
    const int kt4 = (kt + 4 < nkt) ? kt + 4 : nkt - 1;
    ld_tile(kt4, g);
    __syncthreads();
    const int t = o0; o0 = o1; o1 = o2; o2 = t;
  };
  int kt = 0;
  for (; kt + 1 < nkt - 1; kt += 2) { step(kt, gA); step(kt + 1, gB); }
  if (kt < nkt - 1) step(kt, gA);
  softmax_pv(lds + o0, sc);
  __syncthreads();
  const float lam = lambda_full(p, lane);
  const float ltot = xsum32(lsum);
  float* ex = (float*)lds + rg * 4096;
  if (m == 1) { const float i2 = lam / ltot;
#pragma unroll
    for (int et = 0; et < 4; ++et)
#pragma unroll
      for (int i = 0; i < 16; ++i) ex[(et * 32 + crow(i, hh)) * 32 + r] = O[et][i] * i2; }
  __syncthreads();
  if (m == 0) {
    const float i1 = 1.f / ltot; float ss = 0.f;
#pragma unroll
    for (int et = 0; et < 4; ++et)
#pragma unroll
      for (int i = 0; i < 16; ++i) { const float o = O[et][i] * i1 - ex[(et * 32 + crow(i, hh)) * 32 + r]; O[et][i] = o; ss += o * o; }
    ss = xsum32(ss);
    const float rstd = rsqrtf(ss * (1.f / 128.f) + EPSF) * 0.8f;
#pragma unroll
    for (int et = 0; et < 4; ++et)
#pragma unroll
      for (int g = 0; g < 4; ++g) { const int e0 = et * 32 + 8 * g + 4 * hh;
        const f32x4 gs = *(const f32x4*)(p.g_subln + e0);
        const u32x2 ga = *(const u32x2*)(p.gatt + (size_t)tokq * 1024 + hd * 128 + e0);
        const float v0 = O[et][4 * g] * rstd * gs[0] * siluf(bflo(ga.x)), v1 = O[et][4 * g + 1] * rstd * gs[1] * siluf(bfhi(ga.x));
        const float v2 = O[et][4 * g + 2] * rstd * gs[2] * siluf(bflo(ga.y)), v3 = O[et][4 * g + 3] * rstd * gs[3] * siluf(bfhi(ga.y));
        u32x2 w; w.x = pack2(v0, v1); w.y = pack2(v2, v3);
        *(u32x2*)(p.gatt + (size_t)tokq * 1024 + hd * 128 + e0) = w; }
  }
  __syncthreads();
}

DI void phase4(const Params& p, int wv) {
  const int G = gridDim.x;
  const bool xmap = (G & 7) == 0 && (1024 % G) == 0 && (256 % G) == 0;
  for (int it = blockIdx.x; it < 1024; it += G) {
    int b, hd, qb;
    if (xmap) { const int j = blockIdx.x >> 3, i = it / G; const int idx = i * (G >> 3) + j; hd = blockIdx.x & 7; b = idx >> 5; qb = idx & 31; }
    else { b = it >> 8; hd = (it >> 5) & 7; qb = it & 31; }
    attn_item(p, false, b, hd, qb, wv);
  }
  for (int it = blockIdx.x; it < 256; it += G) {
    int b, hd, qb;
    if (xmap) { const int j = blockIdx.x >> 3, i = it / G; const int idx = i * (G >> 3) + j; hd = blockIdx.x & 7; b = idx >> 1; qb = idx & 1; }
    else { b = it >> 4; hd = (it >> 1) & 7; qb = it & 1; }
    attn_item(p, true, b, hd, qb, wv);
  }
  for (int u = blockIdx.x; u < 1280; u += G) lru_unit<true>(p, u, wv);
}

DI void phase5(const Params& p, int wv) {
  TID_DECL const int wr = wave >> 2, wc = wave & 3, r = lane & 31, hh = lane >> 5;
  const bool xmap = gridDim.x == 256;
  for (int i = 0; i < (xmap ? 3 : (640 + (int)gridDim.x - 1) / (int)gridDim.x); ++i) {
    const int u = blockIdx.x + i * gridDim.x;
    int tm, tn;
    if (xmap) { const int x = blockIdx.x & 7, j = blockIdx.x >> 3, s = i * 8 + x; if (s >= 20) break; tm = s * 8 + (j >> 2); tn = j & 3; }
    else { if (u >= 640) break; tm = u >> 2; tn = u & 3; }
    const int m0 = tm * 128, n0 = tn * 256;
    f32x16 acc[2][2];
    gemm_tile<2>(p.gatt, p.glru, 1024, p.woutT, 2048, 2048, m0, n0, acc, wv);
#pragma unroll
    for (int mt = 0; mt < 2; ++mt)
#pragma unroll
      for (int nt = 0; nt < 2; ++nt)
#pragma unroll
        for (int reg = 0; reg < 16; ++reg) p.o2[(size_t)(m0 + wr * 64 + mt * 32 + crow(reg, hh)) * 1024 + n0 + wc * 64 + nt * 32 + r] = acc[mt][nt][reg];
  }
}

DI void phase6(const Params& p, int wv) {
  TID_DECL
  for (int u = blockIdx.x; u < NTOK / NWAVE; u += gridDim.x) {
    const int tok = u * NWAVE + wave; const float* x = xrow(p, tok); const float* md = p.mod + modidx(tok) * 3072 + 2048; const float* o = p.o2 + (size_t)tok * 1024;
    f32x4 ov[4]; float ss = 0.f;
#pragma unroll
    for (int i = 0; i < 4; ++i) { ov[i] = *(const f32x4*)(o + lane * 4 + 256 * i); ss += ov[i][0] * ov[i][0] + ov[i][1] * ov[i][1] + ov[i][2] * ov[i][2] + ov[i][3] * ov[i][3]; }
#pragma unroll
    for (int s = 32; s >= 1; s >>= 1) ss += __shfl_xor(ss, s);
    const float rstd = rsqrtf(ss * (1.f / 1024.f) + EPSF);
#pragma unroll
    for (int i = 0; i < 4; ++i) { const int col = lane * 4 + 256 * i;
      const f32x4 g = *(const f32x4*)(p.g_post + col), gt = *(const f32x4*)(md + col), xv = *(const f32x4*)(x + col);
      f32x4 y;
#pragma unroll
      for (int j = 0; j < 4; ++j) y[j] = xv[j] + gt[j] * (ov[i][j] * rstd * g[j]);
      *(f32x4*)(p.out + (size_t)tok * 1024 + col) = y; }
  }
}

#define XB_TMO      128
#define XB_XCNT(j)  (256  + 64 * (j))
#define XB_XSUB(j)  (1280 + 64 * (j))
#define XB_XGEN(j)  (2304 + 64 * (j))
#define XB_TOP      3328
#define XB_TOPGEN   3392
#define XCD_BAR_WORDS 3456
#define XB_SPIN_CAP (1u << 20)
__shared__ uint4 xb_words;
DI unsigned xb_ld(unsigned* p) { return __hip_atomic_load(p, __ATOMIC_RELAXED, __HIP_MEMORY_SCOPE_AGENT); }
DI unsigned xb_add(unsigned* p, unsigned v) { return __hip_atomic_fetch_add(p, v, __ATOMIC_RELAXED, __HIP_MEMORY_SCOPE_AGENT); }
DI unsigned xb_xcc_id() { return (unsigned)__builtin_amdgcn_s_getreg((3 << 11) | 20) & 0xFu; }
#define XB_SPIN(cond, bar) do { unsigned _sp = 0; while (cond) { __builtin_amdgcn_s_sleep(1); \
    if ((++_sp & 255u) == 0u) { if (xb_ld(&(bar)[XB_TMO])) break; if (_sp > XB_SPIN_CAP) { atomicAdd(&(bar)[XB_TMO], 1u); break; } } } } while (0)
DI void xcd_barrier_complete(unsigned* bar, unsigned x, unsigned& nloc, unsigned& nx) {
  const unsigned G = gridDim.x;
  unsigned sum, cnt, mine, sp = 0u;
  for (;;) {
    sum = 0u; cnt = 0u; mine = 0u;
#pragma unroll
    for (unsigned j = 0; j < 16; ++j) { const unsigned c = xb_ld(&bar[XB_XCNT(j)]); sum += c; cnt += (c > 0u) ? 1u : 0u; mine = (j == x) ? c : mine; }
    if (sum == G) break;
    __builtin_amdgcn_s_sleep(1);
    if ((++sp & 255u) == 0u) { if (xb_ld(&bar[XB_TMO])) break; if (sp > XB_SPIN_CAP) { atomicAdd(&bar[XB_TMO], 1u); break; } }
  }
  nloc = mine > 0u ? mine : 1u; nx = cnt > 0u ? cnt : 1u;
}
DI void grid_barrier(unsigned* bar, bool leader) {
  asm volatile("s_waitcnt vmcnt(0)" ::: "memory");
  __syncthreads();
  if (leader) {
    volatile unsigned* st = (volatile unsigned*)&xb_words;
    const unsigned x = xb_xcc_id();
    __builtin_amdgcn_s_waitcnt(0);
    unsigned nloc = st[0], nx = st[1];
    if (nloc == 0u) { xcd_barrier_complete(bar, x, nloc, nx); st[0] = nloc; st[1] = nx; }
    const unsigned old = xb_add(&bar[XB_XSUB(x)], 1u);
    const unsigned gen = old / nloc;
    if (old + 1u == (gen + 1u) * nloc) {
      __builtin_amdgcn_fence(__ATOMIC_RELEASE, "agent");
      asm volatile("s_waitcnt vmcnt(0)" ::: "memory");
      const unsigned og = xb_add(&bar[XB_TOP], 1u);
      const unsigned tg = og / nx;
      if (og + 1u == (tg + 1u) * nx) xb_add(&bar[XB_TOPGEN], 1u);
      else XB_SPIN(xb_ld(&bar[XB_TOPGEN]) == tg, bar);
      __builtin_amdgcn_fence(__ATOMIC_ACQUIRE, "agent");
      xb_add(&bar[XB_XGEN(x)], 1u);
      asm volatile("s_waitcnt vmcnt(0)" ::: "memory");
    } else {
      XB_SPIN(xb_ld(&bar[XB_XGEN(x)]) == gen, bar);
      __builtin_amdgcn_fence(__ATOMIC_ACQUIRE, "agent");
      asm volatile("s_waitcnt vmcnt(0)" ::: "memory");
    }
  }
  __syncthreads();
}

__global__ void __launch_bounds__(512) fwd_megakernel(Params p) {
  const int lo = p.phase_lo, hi = p.phase_hi;
  const int wv = __builtin_amdgcn_readfirstlane((int)(threadIdx.x >> 6));
  const bool leader = (wv == 0) && (lane_id() == 0);
  if (hi - lo > 1) {
    if (leader) { xb_words = make_uint4(0u, 0u, 0u, 0u); (void)xb_add(&p.bar[XB_XCNT(xb_xcc_id())], 1u); }
    __syncthreads();
  }
  if (lo <= 0 && hi > 0) phase0(p, wv);
  if (lo < 1 && hi > 1) grid_barrier(p.bar, leader);
  if (lo <= 1 && hi > 1) phase1(p, wv);
  if (lo < 2 && hi > 2) grid_barrier(p.bar, leader);
  if (lo <= 2 && hi > 2) phase2(p, wv);
  if (lo < 3 && hi > 3) grid_barrier(p.bar, leader);
  if (lo <= 3 && hi > 3) { for (int u = blockIdx.x; u < 1280; u += gridDim.x) lru_unit<false>(p, u, wv); }
  if (lo < 4 && hi > 4) grid_barrier(p.bar, leader);
  if (lo <= 4 && hi > 4) { phase_carry(p, wv); grid_barrier(p.bar, leader); phase4(p, wv); }
  if (lo < 5 && hi > 5) grid_barrier(p.bar, leader);
  if (lo <= 5 && hi > 5) phase5(p, wv);
  if (lo < 6 && hi > 6) grid_barrier(p.bar, leader);
  if (lo <= 6 && hi > 6) phase6(p, wv);
}

extern "C" void kernel_launch(void* const* d_in, const int* in_sizes, int n_in, void* d_out, int out_size, void* d_ws, size_t ws_size, hipStream_t stream) {
  static int grid_blocks = 0;
  if (!grid_blocks) {
    int dev = 0, cus = 0, per_cu = 0;
    (void)hipGetDevice(&dev);
    (void)hipDeviceGetAttribute(&cus, hipDeviceAttributeMultiprocessorCount, dev);
    (void)hipOccupancyMaxActiveBlocksPerMultiprocessor(&per_cu, fwd_megakernel, NTHR, 0);
    if (per_cu > 1) per_cu = 1;
    if (per_cu < 1) per_cu = 1;
    grid_blocks = cus * per_cu;
  }
  Params p{};
  const float** fp = (const float**)&p;
  for (int i = 0; i < 25; ++i) fp[i] = (const float*)d_in[i];
  p.out = (float*)d_out;
  char* w = (char*)d_ws; size_t off = 0;
  auto take = [&](size_t bytes) { char* r = w + off; off += (bytes + 255) & ~(size_t)255; return r; };
  p.mod = (float*)take(5 * 3072 * 4);
  p.winT = (bf16_t*)take((size_t)6144 * 1024 * 2);
  p.woutT = (bf16_t*)take((size_t)1024 * 2048 * 2);
  p.wgT = (bf16_t*)take((size_t)32 * 16384 * 2);
  p.h = (bf16_t*)d_out;
  p.q = p.h + (size_t)NTOK * 1024;
  p.Kc = (bf16_t*)take((size_t)4096 * 1024 * 2);
  p.Ks = (bf16_t*)take((size_t)4 * 4608 * 1024 * 2);
  p.Vtc = (bf16_t*)take((size_t)16 * 8 * 128 * 256 * 2);
  p.Vts = (bf16_t*)take((size_t)4 * 8 * 128 * 4608 * 2);
  p.gatt = (bf16_t*)take((size_t)NTOK * 1024 * 2);
  p.xlru = (bf16_t*)take((size_t)NTOK * 1024 * 2);
  p.glru = (bf16_t*)take((size_t)NTOK * 1024 * 2);
  p.agg = (float*)take((size_t)2 * 320 * 2048 * 4);
  p.carry = (float*)take((size_t)2 * 320 * 1024 * 4);
  p.o2 = (float*)d_out;
  p.bar = (unsigned*)take(XCD_BAR_WORDS * 4);
  if (off > ws_size) { fprintf(stderr, "workspace too small: need %zu have %zu\n", off, ws_size); return; }
#if MULTI_LAUNCH
  for (int ph = 0; ph < 7; ++ph) { p.phase_lo = ph; p.phase_hi = ph + 1; hipLaunchKernelGGL(fwd_megakernel, dim3(grid_blocks), dim3(NTHR), 0, stream, p); }
#else
  (void)hipMemsetAsync(p.bar, 0, XCD_BAR_WORDS * 4, stream);
  p.phase_lo = 0; p.phase_hi = 7;
  void* args[] = {&p};
  hipError_t e = hipLaunchCooperativeKernel((void*)fwd_megakernel, dim3(grid_blocks), dim3(NTHR), args, 0, stream);
  if (e != hipSuccess) fprintf(stderr, "cooperative launch failed: %s (grid %d)\n", hipGetErrorString(e), grid_blocks);
#endif
}
```

```cpp
#include <hip/hip_runtime.h>
#include <cstdio>
#include <cstdint>

#ifndef MULTI_LAUNCH
#define MULTI_LAUNCH 0
#endif

#define DI __device__ __forceinline__
typedef unsigned short bf16_t;
typedef short bf16x8 __attribute__((ext_vector_type(8)));
typedef float f32x16 __attribute__((ext_vector_type(16)));
typedef float f32x4 __attribute__((ext_vector_type(4)));
typedef float f32x2 __attribute__((ext_vector_type(2)));
typedef unsigned u32x4 __attribute__((ext_vector_type(4)));
typedef unsigned u32x2 __attribute__((ext_vector_type(2)));
typedef __bf16 bf16x2_t __attribute__((ext_vector_type(2)));
#define MFMA32(a, b, c) __builtin_amdgcn_mfma_f32_32x32x16_bf16((a), (b), (c), 0, 0, 0)

constexpr int NTOK = 20480, NCTX = 4096, NTHR = 512, NWAVE = 8;
constexpr float EPSF = 1e-6f;
constexpr int OUT_NK = 20971520, OUT_NV = 25165824, OUT_ST = 29360128;

struct Params {
  const float *x_prompt, *x_sample, *cache_k, *cache_v, *state_lru, *c, *c_ctx, *w_ada, *b_ada, *g_pre, *w_in;
  const float *lq1, *lk1, *lq2, *lk2, *g_subln, *conv_w, *conv_b, *w_rgate, *b_rgate, *w_igate, *b_igate, *lru_lambda, *w_out, *g_post;
  float* out;
  float* mod;
  bf16_t* winT;
  bf16_t* woutT;
  bf16_t* wgT;
  bf16_t* h;
  bf16_t* q;
  bf16_t* Kc;
  bf16_t* Ks;
  bf16_t* Vtc;
  bf16_t* Vts;
  bf16_t* gatt;
  bf16_t* xlru;
  bf16_t* glru;
  float* agg;
  float* carry;
  float* o2;
  unsigned* bar;
  int phase_lo, phase_hi;
};

DI int lane_id() { return (int)__builtin_amdgcn_mbcnt_hi(~0u, __builtin_amdgcn_mbcnt_lo(~0u, 0u)); }
#define TID_DECL int lane_v_ = lane_id(); asm volatile("" : "+v"(lane_v_)); const int lane = lane_v_; const int wave = wv; const int tid = wave * 64 + lane; (void)tid; (void)lane; (void)wave;
DI unsigned pack2(float lo, float hi) { f32x2 v = {lo, hi}; bf16x2_t b = __builtin_convertvector(v, bf16x2_t); return __builtin_bit_cast(unsigned, b); }
DI float bflo(unsigned u) { return __uint_as_float(u << 16); }
DI float bfhi(unsigned u) { return __uint_as_float(u & 0xffff0000u); }
DI float bf1(bf16_t h) { return __uint_as_float(((unsigned)h) << 16); }
DI bf16_t f2bf(float f) { return (bf16_t)(pack2(f, 0.f) & 0xffffu); }
DI float frcp(float x) { return __builtin_amdgcn_rcpf(x); }
DI float siluf(float x) { return x * frcp(1.f + __expf(-x)); }
DI float sigm(float x) { return frcp(1.f + __expf(-x)); }
DI int crow(int reg, int hh) { return (reg & 3) + 8 * (reg >> 2) + 4 * hh; }
typedef unsigned u32x2s __attribute__((ext_vector_type(2)));
DI float xother32(float x, int hh) { const u32x2s t = __builtin_amdgcn_permlane32_swap(__float_as_uint(x), __float_as_uint(x), false, false); return __uint_as_float(hh ? t.x : t.y); }
DI const float* xrow(const Params& p, int tok) { return tok < NCTX ? p.x_prompt + (size_t)tok * 1024 : p.x_sample + (size_t)(tok - NCTX) * 1024; }
DI int modidx(int tok) { return tok < NCTX ? 0 : 1 + ((tok - NCTX) >> 12); }

__shared__ __attribute__((aligned(16))) char lds[131072];

DI void transpose_tile(const float* src, size_t sld, bf16_t* dst, size_t dld, int r0, int c0, float* sm, int wv) {
  const int lx = lane_id(), ly = wv;
#pragma unroll
  for (int i = 0; i < 8; ++i) { const int r = ly + 8 * i; sm[r * 65 + lx] = src[(size_t)(r0 + r) * sld + c0 + lx]; }
  __syncthreads();
  const int rp = lx & 31, cs = lx >> 5;
#pragma unroll
  for (int i = 0; i < 4; ++i) { const int cc = cs + 2 * ly + 16 * i;
    *(unsigned*)(dst + (size_t)(c0 + cc) * dld + r0 + 2 * rp) = pack2(sm[(2 * rp) * 65 + cc], sm[(2 * rp + 1) * 65 + cc]); }
  __syncthreads();
}

DI void mod_unit(const Params& p, int u, int wv) {
  float* sc = (float*)lds;
  float* red = sc + 5120;
  TID_DECL
  for (int i = tid; i < 5120; i += NTHR) { const int mi = i >> 10, k = i & 1023; const float cv = (mi == 0) ? p.c_ctx[k] : p.c[(mi - 1) * 1024 + k]; sc[i] = siluf(cv); }
  __syncthreads();
  const int col = tid & 31, kg = tid >> 5, n = u * 32 + col;
  float a0 = 0.f, a1 = 0.f, a2 = 0.f, a3 = 0.f, a4 = 0.f;
#pragma unroll 8
  for (int k = kg * 64; k < kg * 64 + 64; ++k) {
    const float w = p.w_ada[(size_t)k * 3072 + n];
    a0 += sc[k] * w; a1 += sc[1024 + k] * w; a2 += sc[2048 + k] * w; a3 += sc[3072 + k] * w; a4 += sc[4096 + k] * w;
  }
  red[(kg * 5 + 0) * 32 + col] = a0; red[(kg * 5 + 1) * 32 + col] = a1; red[(kg * 5 + 2) * 32 + col] = a2; red[(kg * 5 + 3) * 32 + col] = a3; red[(kg * 5 + 4) * 32 + col] = a4;
  __syncthreads();
  if (tid < 160) { const int mi = tid >> 5, cc = tid & 31; float s = p.b_ada[u * 32 + cc];
#pragma unroll
    for (int g = 0; g < 16; ++g) s += red[(g * 5 + mi) * 32 + cc];
    p.mod[mi * 3072 + u * 32 + cc] = s; }
  __syncthreads();
}

DI void phase0(const Params& p, int wv) {
  constexpr int NU_MOD = 96, NU_WIN = 1536, NU_WOUT = 512, NU_G = 128, NU_CV = 512, NU_CK = 512;
  constexpr int TOTAL = NU_MOD + NU_WIN + NU_WOUT + NU_G + NU_CV + NU_CK;
  float* sm = (float*)lds;
  for (int u = blockIdx.x; u < TOTAL; u += gridDim.x) {
    int v = u;
    if (v < NU_MOD) { mod_unit(p, v, wv); continue; } v -= NU_MOD;
    if (v < NU_WIN) { const int tr = v / 96, tc = v % 96; transpose_tile(p.w_in, 6144, p.winT, 1024, tr * 64, tc * 64, sm, wv); continue; } v -= NU_WIN;
    if (v < NU_WOUT) { const int tr = v / 16, tc = v % 16; transpose_tile(p.w_out, 1024, p.woutT, 2048, tr * 64, tc * 64, sm, wv); continue; } v -= NU_WOUT;
    if (v < NU_G) { const int mtx = v >> 2, t = v & 3; const int dir = mtx >> 4, gate = (mtx >> 3) & 1, blk = mtx & 7;
      const float* src = (gate ? p.w_igate : p.w_rgate) + (size_t)(dir * 8 + blk) * 16384;
      transpose_tile(src, 128, p.wgT + (size_t)mtx * 16384, 128, (t >> 1) * 64, (t & 1) * 64, sm, wv); continue; } v -= NU_G;
    if (v < NU_CV) { const int bh = v >> 4, t = v & 15; const int b = bh >> 3, hd = bh & 7;
      const float* src = p.cache_v + (size_t)b * 512 * 1024 + hd * 128;
      transpose_tile(src, 1024, p.Vts + (size_t)bh * 128 * 4608, 4608, (t >> 1) * 64, (t & 1) * 64, sm, wv); continue; } v -= NU_CV;
    { const size_t i0 = (size_t)v * 4096 + (wv * 64 + lane_id()) * 8; const size_t b = i0 / (512 * 1024), rem = i0 % (512 * 1024);
      const f32x4 x0 = *(const f32x4*)(p.cache_k + i0), x1 = *(const f32x4*)(p.cache_k + i0 + 4);
      u32x4 w; w.x = pack2(x0[0], x0[1]); w.y = pack2(x0[2], x0[3]); w.z = pack2(x1[0], x1[1]); w.w = pack2(x1[2], x1[3]);
      *(u32x4*)(p.Ks + b * (size_t)4608 * 1024 + rem) = w; }
  }
}

DI void phase1(const Params& p, int wv) {
  TID_DECL
  for (int u = blockIdx.x; u < NTOK / NWAVE; u += gridDim.x) {
    const int tok = u * NWAVE + wave; const float* x = xrow(p, tok); const float* md = p.mod + modidx(tok) * 3072;
    f32x4 xv[4]; float ss = 0.f;
#pragma unroll
    for (int i = 0; i < 4; ++i) { xv[i] = *(const f32x4*)(x + lane * 4 + 256 * i); ss += xv[i][0] * xv[i][0] + xv[i][1] * xv[i][1] + xv[i][2] * xv[i][2] + xv[i][3] * xv[i][3]; }
#pragma unroll
    for (int o = 32; o >= 1; o >>= 1) ss += __shfl_xor(ss, o);
    const float rstd = rsqrtf(ss * (1.f / 1024.f) + EPSF);
#pragma unroll
    for (int i = 0; i < 4; ++i) { const int col = lane * 4 + 256 * i;
      const f32x4 g = *(const f32x4*)(p.g_pre + col), sh = *(const f32x4*)(md + col), scl = *(const f32x4*)(md + 1024 + col);
      float o[4];
#pragma unroll
      for (int j = 0; j < 4; ++j) o[j] = xv[i][j] * rstd * g[j] * (1.f + scl[j]) + sh[j];
      u32x2 w; w.x = pack2(o[0], o[1]); w.y = pack2(o[2], o[3]);
      *(u32x2*)(p.h + (size_t)tok * 1024 + col) = w; }
  }
}

template <int MT> struct GemmRegs { u32x4 a[MT], b[4]; };
template <int MT>
DI void g_load(const bf16_t* A, int lda, const bf16_t* Bt, int ldb, int m0, int n0, int k0, GemmRegs<MT>& g, int tid) {
  const unsigned offa = (unsigned)(((tid >> 3) * lda + (tid & 7) * 8) * 2), offb = (unsigned)(((tid >> 3) * ldb + (tid & 7) * 8) * 2);
  const char* Ab = (const char*)(A + (size_t)m0 * lda + (k0 & 1023));
  const char* Bb = (const char*)(Bt + (size_t)n0 * ldb + k0);
#pragma unroll
  for (int i = 0; i < MT; ++i) g.a[i] = *(const u32x4*)(Ab + (size_t)i * 64 * lda * 2 + offa);
#pragma unroll
  for (int i = 0; i < 4; ++i) g.b[i] = *(const u32x4*)(Bb + (size_t)i * 64 * ldb * 2 + offb);
}
template <int MT>
DI void g_store(char* buf, const GemmRegs<MT>& g, int tid) {
#pragma unroll
  for (int i = 0; i < MT; ++i) { const int id = tid + NTHR * i, row = id >> 3, ch = id & 7; *(u32x4*)(buf + row * 128 + ((ch ^ ((row >> 1) & 7)) << 4)) = g.a[i]; }
#pragma unroll
  for (int i = 0; i < 4; ++i) { const int id = tid + NTHR * i, row = id >> 3, ch = id & 7; *(u32x4*)(buf + MT * 8192 + row * 128 + ((ch ^ ((row >> 1) & 7)) << 4)) = g.b[i]; }
}
template <int MT>
DI void g_compute(const char* buf, f32x16 (&acc)[MT][2], int wr, int wc, int lane, char* nbuf, const GemmRegs<MT>& g, int tid, bool st) {
  const int r = lane & 31, hh = lane >> 5;
#pragma unroll
  for (int ks = 0; ks < 4; ++ks) { const int chunk = 2 * ks + hh; bf16x8 af[MT], bg[2];
#pragma unroll
    for (int mt = 0; mt < MT; ++mt) { const int row = wr * (32 * MT) + mt * 32 + r; af[mt] = *(const bf16x8*)(buf + row * 128 + ((chunk ^ ((row >> 1) & 7)) << 4)); }
#pragma unroll
    for (int nt = 0; nt < 2; ++nt) { const int row = wc * 64 + nt * 32 + r; bg[nt] = *(const bf16x8*)(buf + MT * 8192 + row * 128 + ((chunk ^ ((row >> 1) & 7)) << 4)); }
#pragma unroll
    for (int mt = 0; mt < MT; ++mt)
#pragma unroll
      for (int nt = 0; nt < 2; ++nt) acc[mt][nt] = MFMA32(af[mt], bg[nt], acc[mt][nt]);
    if (st) {
      { const int id = tid + NTHR * ks, row = id >> 3, ch = id & 7; *(u32x4*)(nbuf + MT * 8192 + row * 128 + ((ch ^ ((row >> 1) & 7)) << 4)) = g.b[ks]; }
      if (ks < MT) { const int id = tid + NTHR * ks, row = id >> 3, ch = id & 7; *(u32x4*)(nbuf + row * 128 + ((ch ^ ((row >> 1) & 7)) << 4)) = g.a[ks]; }
    }
  }
}
template <int MT>
DI void gemm_tile(const bf16_t* A, const bf16_t* A2, int lda, const bf16_t* Bt, int ldb, int K, int m0, int n0, f32x16 (&acc)[MT][2], int wv) {
  TID_DECL const int wr = wave >> 2, wc = wave & 3;
  constexpr int STAGE = MT * 8192 + 32768;
  GemmRegs<MT> gA, gB; const int nk = K >> 6;
  auto ldk = [&](int kt, GemmRegs<MT>& g) { const int kc = kt < nk ? kt : nk - 1; g_load<MT>(kc < 16 ? A : A2, lda, Bt, ldb, m0, n0, kc << 6, g, tid); };
  ldk(0, gA); g_store<MT>(lds, gA, tid); ldk(1, gA); ldk(2, gB); __syncthreads();
  __builtin_amdgcn_sched_barrier(0);
#pragma unroll
  for (int mt = 0; mt < MT; ++mt)
#pragma unroll
    for (int nt = 0; nt < 2; ++nt)
#pragma unroll
      for (int i = 0; i < 16; ++i) acc[mt][nt][i] = 0.f;
  for (int kt = 0; kt < nk; kt += 2) {
    g_compute<MT>(lds, acc, wr, wc, lane, lds + STAGE, gA, tid, true);
    ldk(kt + 3, gA);
    __syncthreads();
    g_compute<MT>(lds + STAGE, acc, wr, wc, lane, lds, gB, tid, kt + 2 < nk);
    ldk(kt + 4, gB);
    __syncthreads();
  }
}

DI void phase2(const Params& p, int wv) {
  TID_DECL const int wr = wave >> 2, wc = wave & 3, r = lane & 31, hh = lane >> 5;
  constexpr int NT_N = 24, NT_M = 80;
  const bool xmap = gridDim.x == 256;
  for (int i = 0; i < (xmap ? 8 : (NT_N * NT_M + (int)gridDim.x - 1) / (int)gridDim.x); ++i) {
    const int u = blockIdx.x + i * gridDim.x;
    int tm, tn;
    if (xmap) { const int x = blockIdx.x & 7, j = blockIdx.x >> 3, s = i * 8 + x; if (s >= 60) break; tm = (s / 3) * 4 + (j >> 3); tn = (s % 3) * 8 + (j & 7); }
    else { if (u >= NT_N * NT_M) break; tm = u / NT_N; tn = u % NT_N; }
    const int m0 = tm * 256, n0 = tn * 256;
    f32x16 acc[4][2];
    gemm_tile<4>(p.h, p.h, 1024, p.winT, 1024, 1024, m0, n0, acc, wv);
    const int ctype = n0 >> 10; const bool ctx = m0 < NCTX;
    const int b = ctx ? (m0 >> 8) : ((m0 - NCTX) >> 12);
    int hh_o = hh; asm volatile("" : "+v"(hh_o));
#pragma unroll
    for (int mt = 0; mt < 4; ++mt) {
      const int rowbase = m0 + wr * 128 + mt * 32;
      const int tseq = ctx ? (rowbase & 255) : ((rowbase - NCTX) & 4095);
#pragma unroll
      for (int nt = 0; nt < 2; ++nt) {
        __builtin_amdgcn_sched_barrier(0);
        const int cin = (n0 & 1023) + wc * 64 + nt * 32 + r;
        f32x16 v = acc[mt][nt];
        if (ctype <= 1) {
          if (!ctx) {
            const int i = (lane & 15) + (hh_o & 0); const bool second = (lane & 16) != 0;
            const float inv = __builtin_amdgcn_exp2f(-(float)i * 0.8304820237218405f);
#pragma unroll
            for (int reg = 0; reg < 16; ++reg) {
              const int t = tseq + crow(reg, hh_o);
              const float pos = (nt & 1) ? (float)(t & 63) : (float)(t >> 6);
              const float ang = pos * inv; const float sn = __sinf(ang), cs = __cosf(ang);
              const float x = v[reg]; const float xp = __shfl_xor(x, 16);
              v[reg] = second ? (xp * sn + x * cs) : (x * cs - xp * sn);
            }
          }
          if (ctype == 0) {
#pragma unroll
            for (int reg = 0; reg < 16; ++reg) p.q[(size_t)(rowbase + crow(reg, hh)) * 1024 + cin] = f2bf(v[reg] * 0.18033688011112042f);
          } else {
#pragma unroll
            for (int reg = 0; reg < 16; ++reg) { const int tok = rowbase + crow(reg, hh);
              if (ctx) { p.Kc[(size_t)tok * 1024 + cin] = f2bf(v[reg]); p.out[OUT_NK + (size_t)tok * 1024 + cin] = v[reg]; }
              else { const int t = tseq + crow(reg, hh); p.Ks[((size_t)b * 4608 + 512 + t) * 1024 + cin] = f2bf(v[reg]); } }
          }
        } else if (ctype == 2) {
          const int hd = cin >> 7, e = cin & 127;
          bf16_t* vt = ctx ? p.Vtc + ((size_t)(b * 8 + hd) * 128 + e) * 256 + tseq : p.Vts + ((size_t)(b * 8 + hd) * 128 + e) * 4608 + 512 + tseq;
#pragma unroll
          for (int g = 0; g < 4; ++g) { u32x2 w; w.x = pack2(v[4 * g], v[4 * g + 1]); w.y = pack2(v[4 * g + 2], v[4 * g + 3]); *(u32x2*)(vt + 8 * g + 4 * hh) = w; }
          if (ctx) {
#pragma unroll
            for (int reg = 0; reg < 16; ++reg) p.out[OUT_NV + (size_t)(rowbase + crow(reg, hh)) * 1024 + cin] = v[reg];
          }
        } else {
          bf16_t* dst = (ctype == 3) ? p.gatt : (ctype == 4) ? p.xlru : p.glru;
#pragma unroll
          for (int reg = 0; reg < 16; ++reg) dst[(size_t)(rowbase + crow(reg, hh)) * 1024 + cin] = f2bf(v[reg]);
        }
      }
    }
  }
}

DI float softplusf(float x) { return x > 20.f ? x : log1pf(__expf(x)); }
template <bool PASS2>
DI void lru_unit(const Params& p, int unit, int wv) {
  TID_DECL const int r = lane & 31, hh = lane >> 5;
  const int c2 = unit >> 3, blk = unit & 7; const int tok0 = c2 * 128, ch0 = blk * 128;
  const bool ctx = tok0 < NCTX;
  const int seq_start = ctx ? (tok0 & ~255) : (NCTX + ((tok0 - NCTX) & ~4095)); const int seq_len = ctx ? 256 : 4096;
  const int b = ctx ? (tok0 >> 8) : ((tok0 - NCTX) >> 12);
  char* sU = lds;
  float* sS = (float*)(lds + 32768);
  { const int cc = tid & 15, tg = tid >> 4; const int c8 = ch0 + cc * 8;
    float xin[7][8];
#pragma unroll
    for (int j = 0; j < 7; ++j) { const int tok = tok0 + tg * 4 - 1 + j; const bool ok = tok >= seq_start && tok < seq_start + seq_len;
      u32x4 w = {0u, 0u, 0u, 0u}; if (ok) w = *(const u32x4*)(p.xlru + (size_t)tok * 1024 + c8);
      xin[j][0] = bflo(w.x); xin[j][1] = bfhi(w.x); xin[j][2] = bflo(w.y); xin[j][3] = bfhi(w.y); xin[j][4] = bflo(w.z); xin[j][5] = bfhi(w.z); xin[j][6] = bflo(w.w); xin[j][7] = bfhi(w.w); }
    float cw[4][8], cb[8];
#pragma unroll
    for (int j = 0; j < 4; ++j) { const f32x4 w0 = *(const f32x4*)(p.conv_w + j * 1024 + c8), w1 = *(const f32x4*)(p.conv_w + j * 1024 + c8 + 4);
      cw[j][0] = w0[0]; cw[j][1] = w0[1]; cw[j][2] = w0[2]; cw[j][3] = w0[3]; cw[j][4] = w1[0]; cw[j][5] = w1[1]; cw[j][6] = w1[2]; cw[j][7] = w1[3]; }
    { const f32x4 b0 = *(const f32x4*)(p.conv_b + c8), b1 = *(const f32x4*)(p.conv_b + c8 + 4); cb[0] = b0[0]; cb[1] = b0[1]; cb[2] = b0[2]; cb[3] = b0[3]; cb[4] = b1[0]; cb[5] = b1[1]; cb[6] = b1[2]; cb[7] = b1[3]; }
#pragma unroll
    for (int t = 0; t < 4; ++t) { float uu[8];
#pragma unroll
      for (int e = 0; e < 8; ++e) uu[e] = cb[e] + cw[0][e] * xin[t][e] + cw[1][e] * xin[t + 1][e] + cw[2][e] * xin[t + 2][e] + cw[3][e] * xin[t + 3][e];
      u32x4 w; w.x = pack2(uu[0], uu[1]); w.y = pack2(uu[2], uu[3]); w.z = pack2(uu[4], uu[5]); w.w = pack2(uu[6], uu[7]);
      const int row = tg * 4 + t; *(u32x4*)(sU + row * 256 + ((cc ^ (row & 15)) << 4)) = w; }
  }
  __syncthreads();
  const int cg = wave & 3, th = wave >> 2;
  const int chl = cg * 32 + r, ch = ch0 + chl;
  const int chunk = c2 * 2 + th;
  const int cfirst = seq_start >> 6, clast = (seq_start + seq_len - 64) >> 6;
  float hf[2][16];
#pragma unroll
  for (int dir = 0; dir < 2; ++dir) {
    __builtin_amdgcn_sched_barrier(0);
    f32x16 acc[2][2];
#pragma unroll
    for (int g = 0; g < 2; ++g)
#pragma unroll
      for (int mt = 0; mt < 2; ++mt)
#pragma unroll
        for (int i = 0; i < 16; ++i) acc[g][mt][i] = 0.f;
    const bf16_t* wr_ = p.wgT + ((size_t)((dir * 2 + 0) * 8 + blk) * 128 + chl) * 128;
    const bf16_t* wi_ = p.wgT + ((size_t)((dir * 2 + 1) * 8 + blk) * 128 + chl) * 128;
#pragma unroll
    for (int ks = 0; ks < 8; ++ks) { const int chunkk = 2 * ks + hh;
      const bf16x8 br = *(const bf16x8*)(wr_ + chunkk * 8), bi = *(const bf16x8*)(wi_ + chunkk * 8);
      bf16x8 af[2];
#pragma unroll
      for (int mt = 0; mt < 2; ++mt) { const int row = th * 64 + mt * 32 + r; af[mt] = *(const bf16x8*)(sU + row * 256 + ((chunkk ^ (row & 15)) << 4)); }
#pragma unroll
      for (int mt = 0; mt < 2; ++mt) { acc[0][mt] = MFMA32(af[mt], br, acc[0][mt]); acc[1][mt] = MFMA32(af[mt], bi, acc[1][mt]); }
    }
    __builtin_amdgcn_sched_barrier(0);
    const float brg = p.b_rgate[dir * 1024 + ch], big = p.b_igate[dir * 1024 + ch];
    const float sp8 = -8.f * softplusf(-p.lru_lambda[dir * 1024 + ch]);
#pragma unroll
    for (int mt = 0; mt < 2; ++mt)
#pragma unroll
      for (int reg = 0; reg < 16; ++reg) { const int row = th * 64 + mt * 32 + crow(reg, hh);
        const float rg = sigm(acc[0][mt][reg] + brg), ig = sigm(acc[1][mt][reg] + big);
        const float a = __expf(sp8 * rg);
        const float om = (1.f - a) * (1.f + a);
        const float uv = bf1(*(const bf16_t*)(sU + row * 256 + (((chl >> 3) ^ (row & 15)) << 4) + (chl & 7) * 2));
        acc[0][mt][reg] = a; acc[1][mt][reg] = __builtin_amdgcn_sqrtf(om) * ig * uv; }
    __builtin_amdgcn_sched_barrier(0);
    float GA[8], GB[8], OA[8], OB[8];
#pragma unroll
    for (int mt = 0; mt < 2; ++mt)
#pragma unroll
      for (int g = 0; g < 4; ++g) { const int i = mt * 4 + g;
        const float a0 = acc[0][mt][4 * g], a1 = acc[0][mt][4 * g + 1], a2 = acc[0][mt][4 * g + 2], a3 = acc[0][mt][4 * g + 3];
        const float b0 = acc[1][mt][4 * g], b1 = acc[1][mt][4 * g + 1], b2 = acc[1][mt][4 * g + 2], b3 = acc[1][mt][4 * g + 3];
        GA[i] = (a0 * a1) * (a2 * a3);
        GB[i] = (dir == 0) ? ((b0 * a1 + b1) * a2 + b2) * a3 + b3 : ((b3 * a2 + b2) * a1 + b1) * a0 + b0;
        OA[i] = xother32(GA[i], hh); OB[i] = xother32(GB[i], hh); }
    const bool mefirst = (dir == 0) ? (hh == 0) : (hh == 1);
    float hcar = 0.f;
    if (PASS2) hcar = p.carry[((size_t)dir * 320 + chunk) * 1024 + ch];
    float cin_[8]; float ap = 1.f; float cur = hcar;
#pragma unroll
    for (int ii = 0; ii < 8; ++ii) { const int i = (dir == 0) ? ii : 7 - ii;
      const float fA = mefirst ? GA[i] : OA[i], fB = mefirst ? GB[i] : OB[i], sA_ = mefirst ? OA[i] : GA[i], sB_ = mefirst ? OB[i] : GB[i];
      cin_[i] = mefirst ? cur : (fA * cur + fB);
      cur = sA_ * (fA * cur + fB) + sB_; ap *= fA * sA_; }
    if (!PASS2) { if (hh == 0) { float* ag = p.agg + ((size_t)dir * 320 + chunk) * 2048 + ch; ag[0] = ap; ag[1024] = cur; } }
    else {
#pragma unroll
      for (int mt = 0; mt < 2; ++mt)
#pragma unroll
        for (int g = 0; g < 4; ++g) { const int i = mt * 4 + g; float hv = cin_[i];
          if (dir == 0) {
#pragma unroll
            for (int j = 0; j < 4; ++j) { hv = acc[0][mt][4 * g + j] * hv + acc[1][mt][4 * g + j]; hf[mt][4 * g + j] = hv; }
          } else {
#pragma unroll
            for (int j = 3; j >= 0; --j) { hv = acc[0][mt][4 * g + j] * hv + acc[1][mt][4 * g + j]; hf[mt][4 * g + j] += hv; }
            if (ctx && chunk == cfirst && mt == 0 && g == 0 && hh == 0) p.out[OUT_ST + (size_t)b * 2048 + 1024 + ch] = hv;
          }
        }
      if (dir == 0 && ctx && chunk == clast && hh == 1) p.out[OUT_ST + (size_t)b * 2048 + ch] = hf[1][15];
    }
  }
  if (PASS2) {
#pragma unroll
    for (int mt = 0; mt < 2; ++mt)
#pragma unroll
      for (int reg = 0; reg < 16; ++reg) sS[(th * 64 + mt * 32 + crow(reg, hh)) * 128 + chl] = hf[mt][reg];
    __syncthreads();
    const int cc = tid & 15, tg = tid >> 4;
#pragma unroll
    for (int t = 0; t < 4; ++t) { const int row = tg * 4 + t; const int tok = tok0 + row;
      const f32x4 s0 = *(const f32x4*)(sS + row * 128 + cc * 8), s1 = *(const f32x4*)(sS + row * 128 + cc * 8 + 4);
      const u32x4 gw = *(const u32x4*)(p.glru + (size_t)tok * 1024 + ch0 + cc * 8);
      u32x4 w;
      w.x = pack2(s0[0] * siluf(bflo(gw.x)), s0[1] * siluf(bfhi(gw.x))); w.y = pack2(s0[2] * siluf(bflo(gw.y)), s0[3] * siluf(bfhi(gw.y)));
      w.z = pack2(s1[0] * siluf(bflo(gw.z)), s1[1] * siluf(bfhi(gw.z))); w.w = pack2(s1[2] * siluf(bflo(gw.w)), s1[3] * siluf(bfhi(gw.w)));
      *(u32x4*)(p.glru + (size_t)tok * 1024 + ch0 + cc * 8) = w; }
  }
  __syncthreads();
}

DI void phase_carry(const Params& p, int wv) {
  TID_DECL
  const int g = blockIdx.x * NTHR + tid;
  if (g >= 40960) return;
  const int ch = g & 1023, sq = (g >> 10) % 20, dir = g / 20480;
  const bool ctx = sq < 16;
  const int cfirst = ctx ? sq * 4 : 64 + (sq - 16) * 64, n = ctx ? 4 : 64;
  float h = ctx ? 0.f : p.state_lru[(size_t)(sq - 16) * 2048 + dir * 1024 + ch];
  const float* ag = p.agg + (size_t)dir * 320 * 2048 + ch; float* cy = p.carry + (size_t)dir * 320 * 1024 + ch;
  if (dir == 0) {
#pragma unroll 8
    for (int j = 0; j < n; ++j) { const int c = cfirst + j; const float a = ag[(size_t)c * 2048], b = ag[(size_t)c * 2048 + 1024]; cy[(size_t)c * 1024] = h; h = a * h + b; }
  } else {
#pragma unroll 8
    for (int j = n - 1; j >= 0; --j) { const int c = cfirst + j; const float a = ag[(size_t)c * 2048], b = ag[(size_t)c * 2048 + 1024]; cy[(size_t)c * 1024] = h; h = a * h + b; }
  }
}

DI float lambda_full(const Params& p, int lane) {
  float a = p.lq1[lane] * p.lk1[lane], c = p.lq2[lane] * p.lk2[lane];
#pragma unroll
  for (int o = 32; o >= 1; o >>= 1) { a += __shfl_xor(a, o); c += __shfl_xor(c, o); }
  return __expf(a) - __expf(c) + 0.2f;
}
DI int kperm(int r) { return (r & ~12) | ((r & 4) << 1) | ((r & 8) >> 1); }

typedef unsigned u32x2v __attribute__((ext_vector_type(2)));
DI float xmax32(float x) { const u32x2v t = __builtin_amdgcn_permlane32_swap(__float_as_uint(x), __float_as_uint(x), false, false); return fmaxf(__uint_as_float(t.x), __uint_as_float(t.y)); }
DI float max3f(float a, float b, float c) { float r_; asm("v_max3_f32 %0, %1, %2, %3" : "=v"(r_) : "v"(a), "v"(b), "v"(c)); return r_; }
DI float xsum32(float x) { const u32x2v t = __builtin_amdgcn_permlane32_swap(__float_as_uint(x), __float_as_uint(x), false, false); return __uint_as_float(t.x) + __uint_as_float(t.y); }

DI void attn_item(const Params& p, bool ctx, int b, int hd, int qb, int wv) {
  TID_DECL const int r = lane & 31, hh = lane >> 5;
  const int rg = wave >> 1, m = wave & 1;
  const int Tk = ctx ? 256 : 4608;
  const bf16_t* Kb = (ctx ? p.Kc + (size_t)b * 256 * 1024 : p.Ks + (size_t)b * 4608 * 1024) + hd * 128;
  const bf16_t* Vb = ctx ? p.Vtc + (size_t)(b * 8 + hd) * 128 * 256 : p.Vts + (size_t)(b * 8 + hd) * 128 * 4608;
  const int tokq = (ctx ? b * 256 : NCTX + b * 4096) + qb * 128 + rg * 32 + r;
  bf16x8 qf[4];
#pragma unroll
  for (int ks = 0; ks < 4; ++ks) qf[ks] = *(const bf16x8*)(p.q + (size_t)tokq * 1024 + hd * 128 + m * 64 + ks * 16 + hh * 8);
  f32x16 O[4];
#pragma unroll
  for (int et = 0; et < 4; ++et)
#pragma unroll
    for (int i = 0; i < 16; ++i) O[et][i] = 0.f;
  float mrun, lsum = 0.f;
  const int krow0 = tid >> 4, kch = tid & 15;
  const int vrow0 = tid >> 3, vch = tid & 7;
  struct Stg { u32x4 k[2], v[2]; };
  auto ld_tile = [&](int kt, Stg& g) {
#pragma unroll
    for (int i = 0; i < 2; ++i) {
      g.k[i] = *(const u32x4*)(Kb + (size_t)(kt * 64 + krow0 + 32 * i) * 1024 + kch * 8);
      g.v[i] = *(const u32x4*)(Vb + (size_t)(vrow0 + 64 * i) * Tk + kt * 64 + vch * 8); }
  };
  auto st_tile = [&](char* buf, const Stg& g) {
#pragma unroll
    for (int i = 0; i < 2; ++i) { const int kr_ = krow0 + 32 * i; *(u32x4*)(buf + kr_ * 256 + ((kch ^ (kr_ & 15)) << 4)) = g.k[i];
      const int vr = vrow0 + 64 * i; *(u32x4*)(buf + 16384 + vr * 128 + ((vch ^ ((vr >> 1) & 7)) << 4)) = g.v[i]; }
  };
  const int kr = kperm(r);
#define SB_MEM ((void)0)
  auto compute_S = [&](const char* buf, f32x16 (&s)[2]) {
    bf16x8 kf[2][4];
#pragma unroll
    for (int sub = 0; sub < 2; ++sub) { const int krow = sub * 32 + kr;
#pragma unroll
      for (int ks = 0; ks < 4; ++ks) { const int chunk = m * 8 + 2 * ks + hh; kf[sub][ks] = *(const bf16x8*)(buf + krow * 256 + ((chunk ^ (krow & 15)) << 4)); } }
    SB_MEM;
#pragma unroll
    for (int sub = 0; sub < 2; ++sub)
#pragma unroll
      for (int i = 0; i < 16; ++i) s[sub][i] = 0.f;
#pragma unroll
    for (int ks = 0; ks < 4; ++ks)
#pragma unroll
      for (int sub = 0; sub < 2; ++sub) s[sub] = MFMA32(kf[sub][ks], qf[ks], s[sub]);
    SB_MEM;
  };
  auto rowmax = [&](const f32x16 (&s)[2]) {
    float mx = max3f(s[0][0], s[0][1], s[0][2]);
#pragma unroll
    for (int i = 3; i < 15; i += 2) mx = max3f(mx, s[0][i], s[0][i + 1]);
    mx = max3f(mx, s[0][15], s[1][0]);
#pragma unroll
    for (int i = 1; i < 15; i += 2) mx = max3f(mx, s[1][i], s[1][i + 1]);
    mx = fmaxf(mx, s[1][15]);
    return xmax32(mx);
  };
  auto softmax_pv = [&](const char* buf, const f32x16 (&s)[2]) {
    bf16x8 pf[4]; float ps = 0.f;
#pragma unroll
    for (int sub = 0; sub < 2; ++sub) { float pv[16];
#pragma unroll
      for (int i = 0; i < 16; ++i) { pv[i] = __builtin_amdgcn_exp2f(s[sub][i] - mrun); ps += pv[i]; }
#pragma unroll
      for (int s2 = 0; s2 < 2; ++s2) { u32x4 w; w.x = pack2(pv[8 * s2], pv[8 * s2 + 1]); w.y = pack2(pv[8 * s2 + 2], pv[8 * s2 + 3]); w.z = pack2(pv[8 * s2 + 4], pv[8 * s2 + 5]); w.w = pack2(pv[8 * s2 + 6], pv[8 * s2 + 7]);
        pf[sub * 2 + s2] = __builtin_bit_cast(bf16x8, w); }
    }
    lsum += ps;
    bf16x8 vf[2][4];
#pragma unroll
    for (int et = 0; et < 4; ++et) { const int vr = et * 32 + r; vf[0][et] = *(const bf16x8*)(buf + 16384 + vr * 128 + (((hh) ^ ((vr >> 1) & 7)) << 4)); }
    SB_MEM;
#pragma unroll
    for (int s4 = 0; s4 < 4; ++s4) {
      if (s4 < 3) {
#pragma unroll
        for (int et = 0; et < 4; ++et) { const int vr = et * 32 + r; const int chunk = 2 * (s4 + 1) + hh; vf[(s4 + 1) & 1][et] = *(const bf16x8*)(buf + 16384 + vr * 128 + ((chunk ^ ((vr >> 1) & 7)) << 4)); }
      }
      SB_MEM;
#pragma unroll
      for (int et = 0; et < 4; ++et) O[et] = MFMA32(vf[s4 & 1][et], pf[s4], O[et]);
      SB_MEM;
    }
  };
  const int nkt = Tk >> 6;
  Stg gA, gB;
  ld_tile(0, gA); ld_tile(1, gB); st_tile(lds, gA); st_tile(lds + 32768, gB);
  ld_tile(2, gA); ld_tile(3, gB);
  __syncthreads();
  f32x16 sc[2];
  compute_S(lds, sc);
  mrun = rowmax(sc);
  int o0 = 0, o1 = 32768, o2 = 65536;
  auto step = [&](int kt, Stg& g) {
    st_tile(lds + o2, g);
    { const int kt4 = (kt + 4 < nkt) ? kt + 4 : nkt - 1; ld_tile(kt4, g); }
    f32x16 sn[2];
    compute_S(lds + o1, sn);
    softmax_pv(lds + o0, sc);
    const float mx = rowmax(sn);
    if (__any(mx > mrun + 8.f)) {
      asm volatile("" ::: "memory");
      const float mn = fmaxf(mrun, mx); const float alpha = __builtin_amdgcn_exp2f(mrun - mn); mrun = mn; lsum *= alpha;
#pragma unroll
      for (int et = 0; et < 4; ++et)
#pragma unroll
        for (int i = 0; i < 16; ++i) O[et][i] *= alpha;
    }
#pragma unroll
    for (int sub = 0; sub < 2; ++sub) sc[sub] = sn[sub];
    __syncthreads();
    const int t = o0; o0 = o1; o1 = o2; o2 = t;
  };
  int kt = 0;
  for (; kt + 1 < nkt - 1; kt += 2) { step(kt, gA); step(kt + 1, gB); }
  if (kt < nkt - 1) step(kt, gA);
  softmax_pv(lds + o0, sc);
  __syncthreads();
  const float lam = lambda_full(p, lane);
  const float ltot = xsum32(lsum);
  float* ex = (float*)lds + rg * 4096;
  if (m == 1) { const float i2 = lam / ltot;
#pragma unroll
    for (int et = 0; et < 4; ++et)
#pragma unroll
      for (int i = 0; i < 16; ++i) ex[(et * 32 + crow(i, hh)) * 32 + r] = O[et][i] * i2; }
  __syncthreads();
  if (m == 0) {
    const float i1 = 1.f / ltot; float ss = 0.f;
#pragma unroll
    for (int et = 0; et < 4; ++et)
#pragma unroll
      for (int i = 0; i < 16; ++i) { const float o = O[et][i] * i1 - ex[(et * 32 + crow(i, hh)) * 32 + r]; O[et][i] = o; ss += o * o; }
    ss = xsum32(ss);
    const float rstd = rsqrtf(ss * (1.f / 128.f) + EPSF) * 0.8f;
#pragma unroll
    for (int et = 0; et < 4; ++et)
#pragma unroll
      for (int g = 0; g < 4; ++g) { const int e0 = et * 32 + 8 * g + 4 * hh;
        const f32x4 gs = *(const f32x4*)(p.g_subln + e0);
        const u32x2 ga = *(const u32x2*)(p.gatt + (size_t)tokq * 1024 + hd * 128 + e0);
        const float v0 = O[et][4 * g] * rstd * gs[0] * siluf(bflo(ga.x)), v1 = O[et][4 * g + 1] * rstd * gs[1] * siluf(bfhi(ga.x));
        const float v2 = O[et][4 * g + 2] * rstd * gs[2] * siluf(bflo(ga.y)), v3 = O[et][4 * g + 3] * rstd * gs[3] * siluf(bfhi(ga.y));
        u32x2 w; w.x = pack2(v0, v1); w.y = pack2(v2, v3);
        *(u32x2*)(p.gatt + (size_t)tokq * 1024 + hd * 128 + e0) = w; }
  }
  __syncthreads();
}

DI void phase4(const Params& p, int wv) {
  const int G = gridDim.x;
  const bool xmap = (G & 7) == 0 && (1024 % G) == 0 && (256 % G) == 0;
  for (int it = blockIdx.x; it < 1024; it += G) {
    int b, hd, qb;
    if (xmap) { const int j = blockIdx.x >> 3, i = it / G; const int idx = i * (G >> 3) + j; hd = blockIdx.x & 7; b = idx >> 5; qb = idx & 31; }
    else { b = it >> 8; hd = (it >> 5) & 7; qb = it & 31; }
    attn_item(p, false, b, hd, qb, wv);
  }
  for (int it = blockIdx.x; it < 256; it += G) {
    int b, hd, qb;
    if (xmap) { const int j = blockIdx.x >> 3, i = it / G; const int idx = i * (G >> 3) + j; hd = blockIdx.x & 7; b = idx >> 1; qb = idx & 1; }
    else { b = it >> 4; hd = (it >> 1) & 7; qb = it & 1; }
    attn_item(p, true, b, hd, qb, wv);
  }
  for (int u = blockIdx.x; u < 1280; u += G) lru_unit<true>(p, u, wv);
}

DI void phase5(const Params& p, int wv) {
  TID_DECL const int wr = wave >> 2, wc = wave & 3, r = lane & 31, hh = lane >> 5;
  const bool xmap = gridDim.x == 256;
  for (int i = 0; i < (xmap ? 3 : (640 + (int)gridDim.x - 1) / (int)gridDim.x); ++i) {
    const int u = blockIdx.x + i * gridDim.x;
    int tm, tn;
    if (xmap) { const int x = blockIdx.x & 7, j = blockIdx.x >> 3, s = i * 8 + x; if (s >= 20) break; tm = s * 8 + (j >> 2); tn = j & 3; }
    else { if (u >= 640) break; tm = u >> 2; tn = u & 3; }
    const int m0 = tm * 128, n0 = tn * 256;
    f32x16 acc[2][2];
    gemm_tile<2>(p.gatt, p.glru, 1024, p.woutT, 2048, 2048, m0, n0, acc, wv);
#pragma unroll
    for (int mt = 0; mt < 2; ++mt)
#pragma unroll
      for (int nt = 0; nt < 2; ++nt)
#pragma unroll
        for (int reg = 0; reg < 16; ++reg) p.o2[(size_t)(m0 + wr * 64 + mt * 32 + crow(reg, hh)) * 1024 + n0 + wc * 64 + nt * 32 + r] = acc[mt][nt][reg];
  }
}

DI void phase6(const Params& p, int wv) {
  TID_DECL
  for (int u = blockIdx.x; u < NTOK / NWAVE; u += gridDim.x) {
    const int tok = u * NWAVE + wave; const float* x = xrow(p, tok); const float* md = p.mod + modidx(tok) * 3072 + 2048; const float* o = p.o2 + (size_t)tok * 1024;
    f32x4 ov[4]; float ss = 0.f;
#pragma unroll
    for (int i = 0; i < 4; ++i) { ov[i] = *(const f32x4*)(o + lane * 4 + 256 * i); ss += ov[i][0] * ov[i][0] + ov[i][1] * ov[i][1] + ov[i][2] * ov[i][2] + ov[i][3] * ov[i][3]; }
#pragma unroll
    for (int s = 32; s >= 1; s >>= 1) ss += __shfl_xor(ss, s);
    const float rstd = rsqrtf(ss * (1.f / 1024.f) + EPSF);
#pragma unroll
    for (int i = 0; i < 4; ++i) { const int col = lane * 4 + 256 * i;
      const f32x4 g = *(const f32x4*)(p.g_post + col), gt = *(const f32x4*)(md + col), xv = *(const f32x4*)(x + col);
      f32x4 y;
#pragma unroll
      for (int j = 0; j < 4; ++j) y[j] = xv[j] + gt[j] * (ov[i][j] * rstd * g[j]);
      *(f32x4*)(p.out + (size_t)tok * 1024 + col) = y; }
  }
}

#define XB_TMO      128
#define XB_XCNT(j)  (256  + 64 * (j))
#define XB_XSUB(j)  (1280 + 64 * (j))
#define XB_XGEN(j)  (2304 + 64 * (j))
#define XB_TOP      3328
#define XB_TOPGEN   3392
#define XCD_BAR_WORDS 3456
#define XB_SPIN_CAP (1u << 20)
__shared__ uint4 xb_words;
DI unsigned xb_ld(unsigned* p) { return __hip_atomic_load(p, __ATOMIC_RELAXED, __HIP_MEMORY_SCOPE_AGENT); }
DI unsigned xb_add(unsigned* p, unsigned v) { return __hip_atomic_fetch_add(p, v, __ATOMIC_RELAXED, __HIP_MEMORY_SCOPE_AGENT); }
DI unsigned xb_xcc_id() { return (unsigned)__builtin_amdgcn_s_getreg((3 << 11) | 20) & 0xFu; }
#define XB_SPIN(cond, bar) do { unsigned _sp = 0; while (cond) { __builtin_amdgcn_s_sleep(1); \
    if ((++_sp & 255u) == 0u) { if (xb_ld(&(bar)[XB_TMO])) break; if (_sp > XB_SPIN_CAP) { atomicAdd(&(bar)[XB_TMO], 1u); break; } } } } while (0)
DI void xcd_barrier_complete(unsigned* bar, unsigned x, unsigned& nloc, unsigned& nx) {
  const unsigned G = gridDim.x;
  unsigned sum, cnt, mine, sp = 0u;
  for (;;) {
    sum = 0u; cnt = 0u; mine = 0u;
#pragma unroll
    for (unsigned j = 0; j < 16; ++j) { const unsigned c = xb_ld(&bar[XB_XCNT(j)]); sum += c; cnt += (c > 0u) ? 1u : 0u; mine = (j == x) ? c : mine; }
    if (sum == G) break;
    __builtin_amdgcn_s_sleep(1);
    if ((++sp & 255u) == 0u) { if (xb_ld(&bar[XB_TMO])) break; if (sp > XB_SPIN_CAP) { atomicAdd(&bar[XB_TMO], 1u); break; } }
  }
  nloc = mine > 0u ? mine : 1u; nx = cnt > 0u ? cnt : 1u;
}
DI void grid_barrier(unsigned* bar, bool leader) {
  asm volatile("s_waitcnt vmcnt(0)" ::: "memory");
  __syncthreads();
  if (leader) {
    volatile unsigned* st = (volatile unsigned*)&xb_words;
    const unsigned x = xb_xcc_id();
    __builtin_amdgcn_s_waitcnt(0);
    unsigned nloc = st[0], nx = st[1];
    if (nloc == 0u) { xcd_barrier_complete(bar, x, nloc, nx); st[0] = nloc; st[1] = nx; }
    const unsigned old = xb_add(&bar[XB_XSUB(x)], 1u);
    const unsigned gen = old / nloc;
    if (old + 1u == (gen + 1u) * nloc) {
      __builtin_amdgcn_fence(__ATOMIC_RELEASE, "agent");
      asm volatile("s_waitcnt vmcnt(0)" ::: "memory");
      const unsigned og = xb_add(&bar[XB_TOP], 1u);
      const unsigned tg = og / nx;
      if (og + 1u == (tg + 1u) * nx) xb_add(&bar[XB_TOPGEN], 1u);
      else XB_SPIN(xb_ld(&bar[XB_TOPGEN]) == tg, bar);
      __builtin_amdgcn_fence(__ATOMIC_ACQUIRE, "agent");
      xb_add(&bar[XB_XGEN(x)], 1u);
      asm volatile("s_waitcnt vmcnt(0)" ::: "memory");
    } else {
      XB_SPIN(xb_ld(&bar[XB_XGEN(x)]) == gen, bar);
      __builtin_amdgcn_fence(__ATOMIC_ACQUIRE, "agent");
      asm volatile("s_waitcnt vmcnt(0)" ::: "memory");
    }
  }
  __syncthreads();
}

__global__ void __launch_bounds__(512) fwd_megakernel(Params p) {
  const int lo = p.phase_lo, hi = p.phase_hi;
  const int wv = __builtin_amdgcn_readfirstlane((int)(threadIdx.x >> 6));
  const bool leader = (wv == 0) && (lane_id() == 0);
  if (hi - lo > 1) {
    if (leader) { xb_words = make_uint4(0u, 0u, 0u, 0u); (void)xb_add(&p.bar[XB_XCNT(xb_xcc_id())], 1u); }
    __syncthreads();
  }
  if (lo <= 0 && hi > 0) phase0(p, wv);
  if (lo < 1 && hi > 1) grid_barrier(p.bar, leader);
  if (lo <= 1 && hi > 1) phase1(p, wv);
  if (lo < 2 && hi > 2) grid_barrier(p.bar, leader);
  if (lo <= 2 && hi > 2) phase2(p, wv);
  if (lo < 3 && hi > 3) grid_barrier(p.bar, leader);
  if (lo <= 3 && hi > 3) { for (int u = blockIdx.x; u < 1280; u += gridDim.x) lru_unit<false>(p, u, wv); }
  if (lo < 4 && hi > 4) grid_barrier(p.bar, leader);
  if (lo <= 4 && hi > 4) { phase_carry(p, wv); grid_barrier(p.bar, leader); phase4(p, wv); }
  if (lo < 5 && hi > 5) grid_barrier(p.bar, leader);
  if (lo <= 5 && hi > 5) phase5(p, wv);
  if (lo < 6 && hi > 6) grid_barrier(p.bar, leader);
  if (lo <= 6 && hi > 6) phase6(p, wv);
}

extern "C" void kernel_launch(void* const* d_in, const int* in_sizes, int n_in, void* d_out, int out_size, void* d_ws, size_t ws_size, hipStream_t stream) {
  static int grid_blocks = 0;
  if (!grid_blocks) {
    int dev = 0, cus = 0, per_cu = 0;
    (void)hipGetDevice(&dev);
    (void)hipDeviceGetAttribute(&cus, hipDeviceAttributeMultiprocessorCount, dev);
    (void)hipOccupancyMaxActiveBlocksPerMultiprocessor(&per_cu, fwd_megakernel, NTHR, 0);
    if (per_cu > 1) per_cu = 1;
    if (per_cu < 1) per_cu = 1;
    grid_blocks = cus * per_cu;
  }
  Params p{};
  const float** fp = (const float**)&p;
  for (int i = 0; i < 25; ++i) fp[i] = (const float*)d_in[i];
  p.out = (float*)d_out;
  char* w = (char*)d_ws; size_t off = 0;
  auto take = [&](size_t bytes) { char* r = w + off; off += (bytes + 255) & ~(size_t)255; return r; };
  p.mod = (float*)take(5 * 3072 * 4);
  p.winT = (bf16_t*)take((size_t)6144 * 1024 * 2);
  p.woutT = (bf16_t*)take((size_t)1024 * 2048 * 2);
  p.wgT = (bf16_t*)take((size_t)32 * 16384 * 2);
  p.h = (bf16_t*)d_out;
  p.q = p.h + (size_t)NTOK * 1024;
  p.Kc = (bf16_t*)take((size_t)4096 * 1024 * 2);
  p.Ks = (bf16_t*)take((size_t)4 * 4608 * 1024 * 2);
  p.Vtc = (bf16_t*)take((size_t)16 * 8 * 128 * 256 * 2);
  p.Vts = (bf16_t*)take((size_t)4 * 8 * 128 * 4608 * 2);
  p.gatt = (bf16_t*)take((size_t)NTOK * 1024 * 2);
  p.xlru = (bf16_t*)take((size_t)NTOK * 1024 * 2);
  p.glru = (bf16_t*)take((size_t)NTOK * 1024 * 2);
  p.agg = (float*)take((size_t)2 * 320 * 2048 * 4);
  p.carry = (float*)take((size_t)2 * 320 * 1024 * 4);
  p.o2 = (float*)d_out;
  p.bar = (unsigned*)take(XCD_BAR_WORDS * 4);
  if (off > ws_size) { fprintf(stderr, "workspace too small: need %zu have %zu\n", off, ws_size); return; }
#if MULTI_LAUNCH
  for (int ph = 0; ph < 7; ++ph) { p.phase_lo = ph; p.phase_hi = ph + 1; hipLaunchKernelGGL(fwd_megakernel, dim3(grid_blocks), dim3(NTHR), 0, stream, p); }
#else
  (void)hipMemsetAsync(p.bar, 0, XCD_BAR_WORDS * 4, stream);
  p.phase_lo = 0; p.phase_hi = 7;
  void* args[] = {&p};
  hipError_t e = hipLaunchCooperativeKernel((void*)fwd_megakernel, dim3(grid_blocks), dim3(NTHR), args, 0, stream);
  if (e != hipSuccess) fprintf(stderr, "cooperative launch failed: %s (grid %d)\n", hipGetErrorString(e), grid_blocks);
#endif
}
```

```cpp
#include <hip/hip_runtime.h>
#include <cstdio>
#include <cstdint>

#ifndef MULTI_LAUNCH
#define MULTI_LAUNCH 0
#endif

#define DI __device__ __forceinline__
typedef unsigned short bf16_t;
typedef short bf16x8 __attribute__((ext_vector_type(8)));
typedef float f32x16 __attribute__((ext_vector_type(16)));
typedef float f32x4 __attribute__((ext_vector_type(4)));
typedef float f32x2 __attribute__((ext_vector_type(2)));
typedef unsigned u32x4 __attribute__((ext_vector_type(4)));
typedef unsigned u32x2 __attribute__((ext_vector_type(2)));
typedef __bf16 bf16x2_t __attribute__((ext_vector_type(2)));
#define MFMA32(a, b, c) __builtin_amdgcn_mfma_f32_32x32x16_bf16((a), (b), (c), 0, 0, 0)

constexpr int NTOK = 20480, NCTX = 4096, NTHR = 512, NWAVE = 8;
constexpr float EPSF = 1e-6f;
constexpr int OUT_NK = 20971520, OUT_NV = 25165824, OUT_ST = 29360128;

struct Params {
  const float *x_prompt, *x_sample, *cache_k, *cache_v, *state_lru, *c, *c_ctx, *w_ada, *b_ada, *g_pre, *w_in;
  const float *lq1, *lk1, *lq2, *lk2, *g_subln, *conv_w, *conv_b, *w_rgate, *b_rgate, *w_igate, *b_igate, *lru_lambda, *w_out, *g_post;
  float* out;
  float* mod;
  bf16_t* winT;
  bf16_t* woutT;
  bf16_t* wgT;
  bf16_t* h;
  bf16_t* q;
  bf16_t* Kc;
  bf16_t* Ks;
  bf16_t* Vtc;
  bf16_t* Vts;
  bf16_t* gatt;
  bf16_t* xlru;
  bf16_t* glru;
  float* agg;
  float* carry;
  float* o2;
  float* o2b;
  unsigned* bar;
  int phase_lo, phase_hi;
};

DI int lane_id() { return (int)__builtin_amdgcn_mbcnt_hi(~0u, __builtin_amdgcn_mbcnt_lo(~0u, 0u)); }
#define TID_DECL int lane_v_ = lane_id(); asm volatile("" : "+v"(lane_v_)); const int lane = lane_v_; const int wave = wv; const int tid = wave * 64 + lane; (void)tid; (void)lane; (void)wave;
DI unsigned pack2(float lo, float hi) { f32x2 v = {lo, hi}; bf16x2_t b = __builtin_convertvector(v, bf16x2_t); return __builtin_bit_cast(unsigned, b); }
DI float bflo(unsigned u) { return __uint_as_float(u << 16); }
DI float bfhi(unsigned u) { return __uint_as_float(u & 0xffff0000u); }
DI float bf1(bf16_t h) { return __uint_as_float(((unsigned)h) << 16); }
DI bf16_t f2bf(float f) { return (bf16_t)(pack2(f, 0.f) & 0xffffu); }
DI float frcp(float x) { return __builtin_amdgcn_rcpf(x); }
DI float siluf(float x) { return x * frcp(1.f + __expf(-x)); }
DI float sigm(float x) { return frcp(1.f + __expf(-x)); }
DI int crow(int reg, int hh) { return (reg & 3) + 8 * (reg >> 2) + 4 * hh; }
typedef unsigned u32x2s __attribute__((ext_vector_type(2)));
DI float xother32(float x, int hh) { const u32x2s t = __builtin_amdgcn_permlane32_swap(__float_as_uint(x), __float_as_uint(x), false, false); return __uint_as_float(hh ? t.x : t.y); }
DI const float* xrow(const Params& p, int tok) { return tok < NCTX ? p.x_prompt + (size_t)tok * 1024 : p.x_sample + (size_t)(tok - NCTX) * 1024; }
DI int modidx(int tok) { return tok < NCTX ? 0 : 1 + ((tok - NCTX) >> 12); }

__shared__ __attribute__((aligned(16))) char lds[131072 + 16];

DI void transpose_tile(const float* src, size_t sld, bf16_t* dst, size_t dld, int r0, int c0, float* sm, int wv) {
  const int lx = lane_id(), ly = wv;
#pragma unroll
  for (int i = 0; i < 8; ++i) { const int r = ly + 8 * i; sm[r * 65 + lx] = src[(size_t)(r0 + r) * sld + c0 + lx]; }
  __syncthreads();
  const int rp = lx & 31, cs = lx >> 5;
#pragma unroll
  for (int i = 0; i < 4; ++i) { const int cc = cs + 2 * ly + 16 * i;
    *(unsigned*)(dst + (size_t)(c0 + cc) * dld + r0 + 2 * rp) = pack2(sm[(2 * rp) * 65 + cc], sm[(2 * rp + 1) * 65 + cc]); }
  __syncthreads();
}

DI void transpose_strip(const float* src, size_t sld, bf16_t* dst, size_t dld, int r0, int c0, float* sm, int wv) {
  const int lx = lane_id(), ly = wv;
  f32x4 v[8];
#pragma unroll
  for (int i = 0; i < 8; ++i) v[i] = *(const f32x4*)(src + (size_t)(r0 + ly + 8 * i) * sld + c0 + 4 * lx);
#pragma unroll
  for (int i = 0; i < 8; ++i) { float* row = sm + (ly + 8 * i) * 257 + 4 * lx; row[0] = v[i][0]; row[1] = v[i][1]; row[2] = v[i][2]; row[3] = v[i][3]; }
  __syncthreads();
  const int tid = ly * 64 + lx, rp = tid & 31, cb = tid >> 5;
#pragma unroll
  for (int i = 0; i < 16; ++i) { const int cc = cb + 16 * i;
    *(unsigned*)(dst + (size_t)(c0 + cc) * dld + r0 + 2 * rp) = pack2(sm[(2 * rp) * 257 + cc], sm[(2 * rp + 1) * 257 + cc]); }
  __syncthreads();
}

DI void mod_unit(const Params& p, int u, int wv) {
  float* sc = (float*)lds;
  float* red = sc + 5120;
  TID_DECL
  for (int i = tid; i < 5120; i += NTHR) { const int mi = i >> 10, k = i & 1023; const float cv = (mi == 0) ? p.c_ctx[k] : p.c[(mi - 1) * 1024 + k]; sc[i] = siluf(cv); }
  __syncthreads();
  const int col = tid & 15, kg = tid >> 4, n = u * 16 + col;
  float a0 = 0.f, a1 = 0.f, a2 = 0.f, a3 = 0.f, a4 = 0.f;
#pragma unroll 16
  for (int k = kg * 32; k < kg * 32 + 32; ++k) {
    const float w = p.w_ada[(size_t)k * 3072 + n];
    a0 += sc[k] * w; a1 += sc[1024 + k] * w; a2 += sc[2048 + k] * w; a3 += sc[3072 + k] * w; a4 += sc[4096 + k] * w;
  }
  red[(kg * 5 + 0) * 16 + col] = a0; red[(kg * 5 + 1) * 16 + col] = a1; red[(kg * 5 + 2) * 16 + col] = a2; red[(kg * 5 + 3) * 16 + col] = a3; red[(kg * 5 + 4) * 16 + col] = a4;
  __syncthreads();
  if (tid < 80) { const int mi = tid >> 4, cc = tid & 15; float s = p.b_ada[u * 16 + cc];
#pragma unroll
    for (int g = 0; g < 32; ++g) s += red[(g * 5 + mi) * 16 + cc];
    p.mod[mi * 3072 + u * 16 + cc] = s; }
  __syncthreads();
}

DI void phase0(const Params& p, int wv) {
  constexpr int NU_MOD = 192, NU_WIN = 384, NU_WOUT = 128, NU_G = 128, NU_CV = 128, NU_CK = 512;
  constexpr int TOTAL = NU_MOD + NU_WIN + NU_WOUT + NU_G + NU_CV + NU_CK;
  float* sm = (float*)lds;
  for (int u = blockIdx.x; u < TOTAL; u += gridDim.x) {
    int v = u;
    if (v < NU_MOD) { mod_unit(p, v, wv); continue; } v -= NU_MOD;
    if (v < NU_WIN) { const int tr = v / 24, tc = v % 24; transpose_strip(p.w_in, 6144, p.winT, 1024, tr * 64, tc * 256, sm, wv); continue; } v -= NU_WIN;
    if (v < NU_WOUT) { const int half = v >> 6, t = v & 63; const int tr = t >> 2, tc = t & 3;
      transpose_strip(p.w_out + (size_t)half * 1024 * 1024, 1024, p.woutT + (size_t)half * 1024 * 1024, 1024, tr * 64, tc * 256, sm, wv); continue; } v -= NU_WOUT;
    if (v < NU_G) { const int mtx = v >> 2, t = v & 3; const int dir = mtx >> 4, gate = (mtx >> 3) & 1, blk = mtx & 7;
      const float* src = (gate ? p.w_igate : p.w_rgate) + (size_t)(dir * 8 + blk) * 16384;
      transpose_tile(src, 128, p.wgT + (size_t)mtx * 16384, 128, (t >> 1) * 64, (t & 1) * 64, sm, wv); continue; } v -= NU_G;
    if (v < NU_CV) { const int b = v >> 5, t = v & 31; const int tr = t >> 2, tc = t & 3;
      transpose_strip(p.cache_v + (size_t)b * 512 * 1024, 1024, p.Vts + (size_t)b * 1024 * 4608, 4608, tr * 64, tc * 256, sm, wv); continue; } v -= NU_CV;
    { const size_t i0 = (size_t)v * 4096 + (wv * 64 + lane_id()) * 8; const size_t b = i0 / (512 * 1024), rem = i0 % (512 * 1024);
      const f32x4 x0 = *(const f32x4*)(p.cache_k + i0), x1 = *(const f32x4*)(p.cache_k + i0 + 4);
      u32x4 w; w.x = pack2(x0[0], x0[1]); w.y = pack2(x0[2], x0[3]); w.z = pack2(x1[0], x1[1]); w.w = pack2(x1[2], x1[3]);
      *(u32x4*)(p.Ks + b * (size_t)4608 * 1024 + rem) = w; }
  }
}

DI void phase1(const Params& p, int wv) {
  TID_DECL
#pragma unroll 2
  for (int u = blockIdx.x; u < NTOK / NWAVE; u += gridDim.x) {
    const int tok = u * NWAVE + wave; const float* x = xrow(p, tok); const float* md = p.mod + modidx(tok) * 3072;
    f32x4 xv[4]; float ss = 0.f;
#pragma unroll
    for (int i = 0; i < 4; ++i) { xv[i] = *(const f32x4*)(x + lane * 4 + 256 * i); ss += xv[i][0] * xv[i][0] + xv[i][1] * xv[i][1] + xv[i][2] * xv[i][2] + xv[i][3] * xv[i][3]; }
#pragma unroll
    for (int o = 32; o >= 1; o >>= 1) ss += __shfl_xor(ss, o);
    const float rstd = rsqrtf(ss * (1.f / 1024.f) + EPSF);
#pragma unroll
    for (int i = 0; i < 4; ++i) { const int col = lane * 4 + 256 * i;
      const f32x4 g = *(const f32x4*)(p.g_pre + col), sh = *(const f32x4*)(md + col), scl = *(const f32x4*)(md + 1024 + col);
      float o[4];
#pragma unroll
      for (int j = 0; j < 4; ++j) o[j] = xv[i][j] * rstd * g[j] * (1.f + scl[j]) + sh[j];
      u32x2 w; w.x = pack2(o[0], o[1]); w.y = pack2(o[2], o[3]);
      *(u32x2*)(p.h + (size_t)tok * 1024 + col) = w; }
  }
}

#define LDS_AS(p) ((__attribute__((address_space(3))) unsigned*)(p))
template <int MT>
DI void g_issue(const bf16_t* A, int lda, const bf16_t* Bt, int ldb, int m0, int n0, int k0, char* stage, int tid) {
  const int row0 = tid >> 3, ch = (tid & 7) ^ ((tid >> 4) & 7);
  const unsigned offa = (unsigned)((row0 * lda + ch * 8) * 2), offb = (unsigned)((row0 * ldb + ch * 8) * 2);
  const char* Ab = (const char*)(A + (size_t)m0 * lda + (k0 & 1023));
  const char* Bb = (const char*)(Bt + (size_t)n0 * ldb + k0);
#pragma unroll
  for (int i = 0; i < MT; ++i) __builtin_amdgcn_global_load_lds((const unsigned*)(Ab + (size_t)i * 64 * lda * 2 + offa), LDS_AS(stage + tid * 16 + i * 8192), 16, 0, 0);
#pragma unroll
  for (int i = 0; i < 4; ++i) __builtin_amdgcn_global_load_lds((const unsigned*)(Bb + (size_t)i * 64 * ldb * 2 + offb), LDS_AS(stage + MT * 8192 + tid * 16 + i * 8192), 16, 0, 0);
}
template <int MT>
DI void g_compute(const char* buf, f32x16 (&acc)[MT][2], int wr, int wc, int lane) {
  const int r = lane & 31, hh = lane >> 5;
  bf16x8 af[2][MT], bg[2][2];
  auto rd = [&](int ks, int s) { const int chunk = 2 * ks + hh;
#pragma unroll
    for (int nt = 0; nt < 2; ++nt) { const int row = wc * 64 + nt * 32 + r; bg[s][nt] = *(const bf16x8*)(buf + MT * 8192 + row * 128 + ((chunk ^ ((row >> 1) & 7)) << 4)); }
#pragma unroll
    for (int mt = 0; mt < MT; ++mt) { const int row = wr * (32 * MT) + mt * 32 + r; af[s][mt] = *(const bf16x8*)(buf + row * 128 + ((chunk ^ ((row >> 1) & 7)) << 4)); } };
  rd(0, 0);
  __builtin_amdgcn_sched_barrier(0);
#pragma unroll
  for (int ks = 0; ks < 4; ++ks) {
    if (ks < 3) rd(ks + 1, (ks + 1) & 1);
    __builtin_amdgcn_sched_barrier(0);
#pragma unroll
    for (int mt = 0; mt < MT; ++mt)
#pragma unroll
      for (int nt = 0; nt < 2; ++nt) acc[mt][nt] = MFMA32(af[ks & 1][mt], bg[ks & 1][nt], acc[mt][nt]);
    __builtin_amdgcn_sched_barrier(0);
  }
}
template <int MT>
DI void gemm_tile(const bf16_t* A, const bf16_t* A2, int lda, const bf16_t* Bt, int ldb, int K, int m0, int n0, f32x16 (&acc)[MT][2], int wv) {
  TID_DECL const int wr = wave >> 2, wc = wave & 3;
  constexpr int STAGE = MT * 8192 + 32768;
  const int nk = K >> 6;
  g_issue<MT>(A, lda, Bt, ldb, m0, n0, 0, lds, tid);
#pragma unroll
  for (int mt = 0; mt < MT; ++mt)
#pragma unroll
    for (int nt = 0; nt < 2; ++nt)
#pragma unroll
      for (int i = 0; i < 16; ++i) acc[mt][nt][i] = 0.f;
  __syncthreads();
  for (int kt = 0; kt < nk; kt += 2) {
    g_issue<MT>((kt + 1) < 16 ? A : A2, lda, Bt, ldb, m0, n0, (kt + 1) << 6, lds + STAGE, tid);
    g_compute<MT>(lds, acc, wr, wc, lane);
    __syncthreads();
    if (kt + 2 < nk) g_issue<MT>((kt + 2) < 16 ? A : A2, lda, Bt, ldb, m0, n0, (kt + 2) << 6, lds, tid);
    g_compute<MT>(lds + STAGE, acc, wr, wc, lane);
    __syncthreads();
  }
}

namespace pg8 {
#define PG8_LAS __attribute__((address_space(3)))
constexpr int BM = 256, BK = 64, HALF = 128, HTB = HALF * BK * 2  , STAGE_BYTES = 8 * HTB, NXCD = 8, WGM = 8;

__host__ __device__ __forceinline__ int lds_byte(int r, int c) { const int st = (r >> 4) * 2 + (c >> 5), rr = r & 15, cc = c & 31, ob = rr * 64 + cc * 2; return st * 1024 + (ob ^ (((ob >> 9) & 1) << 5)); }
__host__ __device__ __forceinline__ void stage_rc(int b, int& R, int& C) { const int st = b / 1024, sb = b % 1024, swz = sb ^ (((sb >> 9) & 1) << 5); R = (st >> 1) * 16 + swz / 64; C = (st & 1) * 32 + (swz % 64) / 2; }
__host__ __device__ __forceinline__ int perm32(int rho) { const int n = rho >> 4, i = rho & 15; return 8 * (i >> 2) + 4 * n + (i & 3); }
struct Unit { int pm, pn, type; const char* a; const char* b; };
template <class Epi, class Sched, bool ALIGN_EPI = false, bool SP2 = false>
__device__ __forceinline__ void gemm_phase(PG8_LAS unsigned char* lds, const int K, const Sched& S, const Epi& E, const int tid_in, const int wid_in) {
    const int tid = tid_in, wid = wid_in, lane = tid & 63, wr = wid >> 2, wc = wid & 3, fr = lane & 15, fq = lane >> 4;
    const int nt = K / BK;
    unsigned voffA[2], voffB[2];
#pragma unroll
    for (int i = 0; i < 2; ++i) { int R, C; stage_rc(tid * 16 + i * 8192, R, C); const int Rb = Epi::PERM ? ((R & ~31) + perm32(R & 31)) : R;
        voffA[i] = (unsigned)(R * K + C) * 2u; voffB[i] = (unsigned)(Rb * K + C) * 2u; }
    const size_t kstep = (size_t)(BK * 2);
    const size_t hstep = (size_t)HALF * K * 2;
    const size_t tstep = 2 * hstep; (void)tstep;
    const unsigned ldsw = (unsigned)wid * 1024u;
    const int aoff = lds_byte(wr * 64 + fr, fq * 8), boff = lds_byte(wc * 32 + fr, fq * 8);
#define PG8_SA(b, h) (((b) * 2 + (h)) * HTB)
#define PG8_SB(b, h) ((4 + (b) * 2 + (h)) * HTB)
#define PG8_STAGE(bufoff, gbase, voff) do { _Pragma("unroll") for (int _i = 0; _i < 2; ++_i) \
        __builtin_amdgcn_global_load_lds((const unsigned*)((const char*)(gbase) + (voff)[_i]), (PG8_LAS unsigned*)(lds + (bufoff) + ldsw + _i * 8192), 16, 0, 0); } while (0)
#define PG8_LDA(dst, b, h) do { _Pragma("unroll") for (int m = 0; m < 4; ++m) _Pragma("unroll") for (int k = 0; k < 2; ++k) dst[m][k] = *(const PG8_LAS bf16x8*)(lds + PG8_SA(b, h) + aoff + m * 2048 + k * 1024); } while (0)
#define PG8_LDB(dst, b, h) do { _Pragma("unroll") for (int n = 0; n < 2; ++n) _Pragma("unroll") for (int k = 0; k < 2; ++k) dst[n][k] = *(const PG8_LAS bf16x8*)(lds + PG8_SB(b, h) + boff + n * 2048 + k * 1024); } while (0)
#define PG8_MMA(ai, bj, At, Bt) do { __builtin_amdgcn_s_setprio(1); _Pragma("unroll") for (int m = 0; m < 4; ++m) _Pragma("unroll") for (int n = 0; n < 2; ++n) _Pragma("unroll") for (int k = 0; k < 2; ++k) \
        acc[ai][bj][m][n] = __builtin_amdgcn_mfma_f32_16x16x32_bf16(Bt[n][k], At[m][k], acc[ai][bj][m][n], 0, 0, 0); __builtin_amdgcn_s_setprio(0); } while (0)
#define PG8_WAIT_V(n) asm volatile("s_waitcnt vmcnt(" #n ")" ::: "memory")
#define PG8_WAIT_L(n) asm volatile("s_waitcnt lgkmcnt(" #n ")" ::: "memory")
#define PG8_BAR __builtin_amdgcn_s_barrier()
#define PG8_SCHED __builtin_amdgcn_sched_barrier(0)
    Unit cur, nxt; int ui = 0;
    if (!S.next(0, cur)) return;
    f32x4 acc[2][2][4][2];
#pragma unroll
    for (int a = 0; a < 2; ++a)
#pragma unroll
        for (int b = 0; b < 2; ++b)
#pragma unroll
            for (int m = 0; m < 4; ++m)
#pragma unroll
                for (int n = 0; n < 2; ++n) acc[a][b][m][n] = (f32x4){0.f, 0.f, 0.f, 0.f};
    bf16x8 At[4][2], B0[2][2], B1[2][2];
    const char* cA = cur.a; const char* cB = cur.b;
    S.a_ready(cur);
    if constexpr (SP2) {
        PG8_STAGE(PG8_SB(0, 0), cB, voffB); PG8_STAGE(PG8_SB(0, 1), cB + hstep, voffB); PG8_STAGE(PG8_SA(0, 0), cA, voffA); PG8_STAGE(PG8_SA(0, 1), cA + hstep, voffA);
        if (wr == 1) PG8_BAR;
        PG8_WAIT_V(2); PG8_BAR;
        PG8_STAGE(PG8_SB(1, 0), cB + kstep, voffB); PG8_STAGE(PG8_SA(1, 0), cA + kstep, voffA); PG8_STAGE(PG8_SB(1, 1), cB + hstep + kstep, voffB);
        PG8_WAIT_V(6); PG8_BAR;
    } else {
        PG8_STAGE(PG8_SB(0, 0), cB, voffB); PG8_STAGE(PG8_SA(0, 0), cA, voffA); PG8_STAGE(PG8_SB(0, 1), cB + hstep, voffB); PG8_STAGE(PG8_SA(0, 1), cA + hstep, voffA);
        if (wr == 1) PG8_BAR;
        PG8_WAIT_V(4); PG8_BAR;
        PG8_STAGE(PG8_SB(1, 0), cB + kstep, voffB); PG8_STAGE(PG8_SA(1, 0), cA + kstep, voffA); PG8_STAGE(PG8_SB(1, 1), cB + hstep + kstep, voffB);
        PG8_WAIT_V(6); PG8_BAR;
    }
    for (;;) {
        const bool has_next = S.next(ui + 1, nxt);
        const char* nA = has_next ? nxt.a : cA; const char* nB = has_next ? nxt.b : cB;
        for (int t = 0; t < nt; t += 2) {
            const bool last = (t == nt - 2);
            const char* a1 = cA + (size_t)(t + 1) * kstep;
            const char* a2 = last ? nA : cA + (size_t)(t + 2) * kstep; const char* b2 = last ? nB : cB + (size_t)(t + 2) * kstep;
            const char* a3 = a2 + kstep; const char* b3 = b2 + kstep;
            if (last && has_next) S.a_ready(nxt);
            if constexpr (SP2) {
            PG8_LDB(B0, 0, 0); PG8_LDB(B1, 0, 1); PG8_SCHED; PG8_LDA(At, 0, 0); PG8_STAGE(PG8_SA(1, 1), a1 + hstep, voffA);
            PG8_WAIT_V(8); PG8_WAIT_L(0); PG8_BAR; PG8_MMA(0, 0, At, B0); PG8_MMA(0, 1, At, B1); PG8_BAR; PG8_SCHED;
            PG8_LDA(At, 0, 1); PG8_STAGE(PG8_SB(0, 0), b2, voffB); PG8_STAGE(PG8_SB(0, 1), b2 + hstep, voffB); PG8_STAGE(PG8_SA(0, 0), a2, voffA);
            PG8_WAIT_V(8); PG8_WAIT_L(0); PG8_BAR; PG8_MMA(1, 0, At, B0); PG8_MMA(1, 1, At, B1); PG8_BAR; PG8_SCHED;
            PG8_LDB(B0, 1, 0); PG8_LDB(B1, 1, 1); PG8_SCHED; PG8_LDA(At, 1, 0); PG8_STAGE(PG8_SA(0, 1), a2 + hstep, voffA);
            PG8_WAIT_V(8); PG8_WAIT_L(0); PG8_BAR; PG8_MMA(0, 0, At, B0); PG8_MMA(0, 1, At, B1); PG8_BAR; PG8_SCHED;
            PG8_LDA(At, 1, 1); PG8_STAGE(PG8_SB(1, 0), b3, voffB); PG8_STAGE(PG8_SB(1, 1), b3 + hstep, voffB); PG8_STAGE(PG8_SA(1, 0), a3, voffA);
            PG8_WAIT_V(8); PG8_WAIT_L(0); PG8_BAR; PG8_MMA(1, 0, At, B0); PG8_MMA(1, 1, At, B1); PG8_BAR; PG8_SCHED;
            } else {
            PG8_LDB(B0, 0, 0); PG8_SCHED; PG8_LDA(At, 0, 0); PG8_STAGE(PG8_SA(1, 1), a1 + hstep, voffA);
            PG8_WAIT_L(8); PG8_BAR; PG8_WAIT_L(0); PG8_MMA(0, 0, At, B0); PG8_BAR; PG8_SCHED;
            PG8_LDB(B1, 0, 1); PG8_STAGE(PG8_SB(0, 0), b2, voffB);
            PG8_BAR; PG8_WAIT_L(0); PG8_MMA(0, 1, At, B1); PG8_BAR;
            PG8_LDA(At, 0, 1); PG8_STAGE(PG8_SA(0, 0), a2, voffA);
            PG8_BAR; PG8_WAIT_L(0); PG8_MMA(1, 0, At, B0); PG8_BAR; PG8_SCHED;
            PG8_STAGE(PG8_SB(0, 1), b2 + hstep, voffB);
            PG8_WAIT_V(6); PG8_BAR; PG8_MMA(1, 1, At, B1); PG8_BAR;
            PG8_LDB(B0, 1, 0); PG8_SCHED; PG8_LDA(At, 1, 0); PG8_STAGE(PG8_SA(0, 1), a2 + hstep, voffA);
            PG8_WAIT_L(8); PG8_BAR; PG8_WAIT_L(0); PG8_MMA(0, 0, At, B0); PG8_BAR; PG8_SCHED;
            PG8_LDB(B1, 1, 1); PG8_STAGE(PG8_SB(1, 0), b3, voffB);
            PG8_BAR; PG8_WAIT_L(0); PG8_MMA(0, 1, At, B1); PG8_BAR;
            PG8_LDA(At, 1, 1); PG8_STAGE(PG8_SA(1, 0), a3, voffA);
            PG8_BAR; PG8_WAIT_L(0); PG8_MMA(1, 0, At, B0); PG8_BAR; PG8_SCHED;
            PG8_STAGE(PG8_SB(1, 1), b3 + hstep, voffB);
            PG8_WAIT_V(6); PG8_BAR; PG8_MMA(1, 1, At, B1); PG8_BAR;
            }
        }
        if constexpr (ALIGN_EPI) { if (wr == 0) PG8_BAR; }
        if constexpr (!Epi::AFTER_DRAIN) { E(acc, cur, wr, wc, fr, fq); S.done(cur); }
        if (!has_next) break;
#pragma unroll
        for (int a = 0; a < 2; ++a)
#pragma unroll
            for (int b = 0; b < 2; ++b)
#pragma unroll
                for (int m = 0; m < 4; ++m)
#pragma unroll
                    for (int n = 0; n < 2; ++n) acc[a][b][m][n] = (f32x4){0.f, 0.f, 0.f, 0.f};
        cur = nxt; cA = nA; cB = nB; ++ui;
        if constexpr (ALIGN_EPI) { if (wr == 1) PG8_BAR; }
    }
    PG8_WAIT_V(0);
    if constexpr (!ALIGN_EPI) { if (wr == 0) PG8_BAR; }
    PG8_BAR;
    if constexpr (Epi::AFTER_DRAIN) { E.fused(acc, cur, wr, wc, fr, fq, lds, wid, lane); S.done(cur); }
#undef PG8_SA
#undef PG8_SB
#undef PG8_STAGE
#undef PG8_LDA
#undef PG8_LDB
#undef PG8_MMA
#undef PG8_WAIT_V
#undef PG8_WAIT_L
#undef PG8_BAR
#undef PG8_SCHED
}
}

struct SchedIn {
  const bf16_t* h; const bf16_t* winT; int G, c;
  DI bool next(int i, pg8::Unit& u) const {
    const int L = i * G + c; if (L >= 1920) return false;
    if (L < 1600) {
      const int wg = (G == 256) ? (L & 7) * 200 + (L >> 3) : L; const int tm = (wg / 160) * 8 + (wg % 160) % 8, tn = (wg % 160) / 8; u.pm = tm; u.pn = tn < 8 ? tn : tn + 4; u.type = 0; u.a = (const char*)(h + (size_t)tm * 256 * 1024); u.b = (const char*)(winT + (size_t)u.pn * 256 * 1024); }
    else { const int v0 = L - 1600; const int v = (G == 256) ? (L & 7) * 40 + (v0 >> 3) : v0;
      u.pm = v & 3; u.pn = v >> 2; u.type = 1; u.a = (const char*)(winT + (size_t)(2048 + u.pm * 256) * 1024); u.b = (const char*)(h + (size_t)u.pn * 256 * 1024); }
    return true; }
  DI void a_ready(const pg8::Unit&) const {}
  DI void done(const pg8::Unit&) const {}
};
DI u32x4 pack8(const f32x4& a, const f32x4& b) { u32x4 w; w.x = pack2(a[0], a[1]); w.y = pack2(a[2], a[3]); w.z = pack2(b[0], b[1]); w.w = pack2(b[2], b[3]); return w; }
struct EpiIn {
  static constexpr bool PERM = true, AFTER_DRAIN = false;
  struct { bf16_t *q, *Kc, *Ks, *Vtc, *Vts, *gatt, *xlru, *glru; float* out; } p;
  DI void operator()(const f32x4 (&acc)[2][2][4][2], const pg8::Unit& u, int wr, int wc, int fr, int fq) const {
    if (u.type == 0) {
      const int m0 = u.pm * 256, n0 = u.pn * 256;
      const int ctype = n0 >> 10; const bool ctx = m0 < NCTX; const bool rope = (ctype <= 1) && !ctx;
      const int b = ctx ? (m0 >> 8) : ((m0 - NCTX) >> 12);
      const int hh = fq >> 1;
      float inv[2][4];
#pragma unroll
      for (int n = 0; n < 2; ++n)
#pragma unroll
        for (int j = 0; j < 4; ++j) inv[n][j] = __builtin_amdgcn_exp2f(-(float)(8 * (fq & 1) + 4 * n + j) * 0.8304820237218405f);
#pragma unroll
      for (int ai = 0; ai < 2; ++ai)
#pragma unroll
        for (int m = 0; m < 4; ++m) {
          __builtin_amdgcn_sched_barrier(0);
          const int tok = m0 + 128 * ai + 64 * wr + 16 * m + fr;
          const int t = ctx ? (tok & 255) : ((tok - NCTX) & 4095);
          float sn[2][4], cs[2][4];
          if (rope) { const float pos = (wc & 1) ? (float)(t & 63) : (float)(t >> 6);
#pragma unroll
            for (int n = 0; n < 2; ++n)
#pragma unroll
              for (int j = 0; j < 4; ++j) { const float ang = pos * inv[n][j]; sn[n][j] = __sinf(ang); cs[n][j] = __cosf(ang); } }
#pragma unroll
          for (int bj = 0; bj < 2; ++bj) {
            f32x4 v[2] = {acc[ai][bj][m][0], acc[ai][bj][m][1]};
            const int col = (n0 & 1023) + 128 * bj + 32 * wc + 8 * fq;
            if (rope) {
#pragma unroll
              for (int n = 0; n < 2; ++n)
#pragma unroll
                for (int j = 0; j < 4; ++j) { const float x = v[n][j]; const float xp = xother32(x, hh); v[n][j] = hh ? (xp * sn[n][j] + x * cs[n][j]) : (x * cs[n][j] - xp * sn[n][j]); }
            }
            if (ctype == 0) { v[0] = v[0] * 0.18033688011112042f; v[1] = v[1] * 0.18033688011112042f; *(u32x4*)(p.q + (size_t)tok * 1024 + col) = pack8(v[0], v[1]); }
            else if (ctype == 1) {
              if (ctx) { *(u32x4*)(p.Kc + (size_t)tok * 1024 + col) = pack8(v[0], v[1]); *(f32x4*)(p.out + OUT_NK + (size_t)tok * 1024 + col) = v[0]; *(f32x4*)(p.out + OUT_NK + (size_t)tok * 1024 + col + 4) = v[1]; }
              else *(u32x4*)(p.Ks + ((size_t)b * 4608 + 512 + t) * 1024 + col) = pack8(v[0], v[1]);
            } else if (ctype == 3) *(u32x4*)(p.gatt + (size_t)tok * 1024 + col) = pack8(v[0], v[1]);
            else if (ctype == 4) *(u32x4*)(p.xlru + (size_t)tok * 1024 + col) = pack8(v[0], v[1]);
            else if (ctype == 5) *(u32x4*)(p.glru + (size_t)tok * 1024 + col) = pack8(v[0], v[1]);
          }
        }
    } else {
      const int e0 = u.pm * 256, tk0 = u.pn * 256; const bool ctx = tk0 < NCTX;
      const int b = ctx ? (tk0 >> 8) : ((tk0 - NCTX) >> 12);
#pragma unroll
      for (int ai = 0; ai < 2; ++ai)
#pragma unroll
        for (int m = 0; m < 4; ++m) { const int erow = e0 + 128 * ai + 64 * wr + 16 * m + fr; const int hd = erow >> 7, ee = erow & 127;
#pragma unroll
          for (int bj = 0; bj < 2; ++bj) { const int tok = tk0 + 128 * bj + 32 * wc + 8 * fq; const int t = ctx ? (tok & 255) : ((tok - NCTX) & 4095);
            bf16_t* vt = ctx ? p.Vtc + ((size_t)(b * 8 + hd) * 128 + ee) * 256 + t : p.Vts + ((size_t)(b * 8 + hd) * 128 + ee) * 4608 + 512 + t;
            *(u32x4*)vt = pack8(acc[ai][bj][m][0], acc[ai][bj][m][1]);
            if (ctx) {
#pragma unroll
              for (int n = 0; n < 2; ++n)
#pragma unroll
                for (int j = 0; j < 4; ++j) p.out[OUT_NV + (size_t)(tok + 4 * n + j) * 1024 + erow] = acc[ai][bj][m][n][j];
            }
          } }
    }
  }
};
DI void phase2(const Params& p, int wv) {
  TID_DECL
  SchedIn S{p.h, p.winT, (int)gridDim.x, (int)blockIdx.x};
  EpiIn E{{p.q, p.Kc, p.Ks, p.Vtc, p.Vts, p.gatt, p.xlru, p.glru, p.out}};
  pg8::gemm_phase<EpiIn, SchedIn, true, true>((PG8_LAS unsigned char*)lds, 1024, S, E, tid, wave);
}

DI float softplusf(float x) { return x > 20.f ? x : log1pf(__expf(x)); }
template <bool PASS2>
DI void lru_unit(const Params& p, int unit, int wv) {
  TID_DECL const int r = lane & 31, hh = lane >> 5;
  const int c2 = unit >> 3, blk = unit & 7; const int tok0 = c2 * 128, ch0 = blk * 128;
  const bool ctx = tok0 < NCTX;
  const int seq_start = ctx ? (tok0 & ~255) : (NCTX + ((tok0 - NCTX) & ~4095)); const int seq_len = ctx ? 256 : 4096;
  const int b = ctx ? (tok0 >> 8) : ((tok0 - NCTX) >> 12);
  char* sU = lds;
  float* sS = (float*)(lds + 32768);
  const int cg_ = wave & 3; const int chl_ = cg_ * 32 + r;
  bf16x8 bw[2][8];
  auto ldw = [&](int dir) {
#pragma unroll
    for (int g = 0; g < 2; ++g) { const bf16_t* wp = p.wgT + ((size_t)((dir * 2 + g) * 8 + blk) * 128 + chl_) * 128;
#pragma unroll
      for (int ks = 0; ks < 8; ++ks) bw[g][ks] = *(const bf16x8*)(wp + (2 * ks + hh) * 8); }
  };
  ldw(0);
  { const int cc = tid & 15, tg = tid >> 4; const int c8 = ch0 + cc * 8;
    float xin[7][8];
#pragma unroll
    for (int j = 0; j < 7; ++j) { const int tok = tok0 + tg * 4 - 1 + j; const bool ok = tok >= seq_start && tok < seq_start + seq_len;
      u32x4 w = {0u, 0u, 0u, 0u}; if (ok) w = *(const u32x4*)(p.xlru + (size_t)tok * 1024 + c8);
      xin[j][0] = bflo(w.x); xin[j][1] = bfhi(w.x); xin[j][2] = bflo(w.y); xin[j][3] = bfhi(w.y); xin[j][4] = bflo(w.z); xin[j][5] = bfhi(w.z); xin[j][6] = bflo(w.w); xin[j][7] = bfhi(w.w); }
    float cw[4][8], cb[8];
#pragma unroll
    for (int j = 0; j < 4; ++j) { const f32x4 w0 = *(const f32x4*)(p.conv_w + j * 1024 + c8), w1 = *(const f32x4*)(p.conv_w + j * 1024 + c8 + 4);
      cw[j][0] = w0[0]; cw[j][1] = w0[1]; cw[j][2] = w0[2]; cw[j][3] = w0[3]; cw[j][4] = w1[0]; cw[j][5] = w1[1]; cw[j][6] = w1[2]; cw[j][7] = w1[3]; }
    { const f32x4 b0 = *(const f32x4*)(p.conv_b + c8), b1 = *(const f32x4*)(p.conv_b + c8 + 4); cb[0] = b0[0]; cb[1] = b0[1]; cb[2] = b0[2]; cb[3] = b0[3]; cb[4] = b1[0]; cb[5] = b1[1]; cb[6] = b1[2]; cb[7] = b1[3]; }
#pragma unroll
    for (int t = 0; t < 4; ++t) { float uu[8];
#pragma unroll
      for (int e = 0; e < 8; ++e) uu[e] = cb[e] + cw[0][e] * xin[t][e] + cw[1][e] * xin[t + 1][e] + cw[2][e] * xin[t + 2][e] + cw[3][e] * xin[t + 3][e];
      u32x4 w; w.x = pack2(uu[0], uu[1]); w.y = pack2(uu[2], uu[3]); w.z = pack2(uu[4], uu[5]); w.w = pack2(uu[6], uu[7]);
      const int row = tg * 4 + t; *(u32x4*)(sU + row * 256 + ((cc ^ (row & 15)) << 4)) = w; }
  }
  __syncthreads();
  const int cg = wave & 3, th = wave >> 2;
  const int chl = cg * 32 + r, ch = ch0 + chl;
  const int chunk = c2 * 2 + th;
  const int cfirst = seq_start >> 6, clast = (seq_start + seq_len - 64) >> 6;
  f32x16 uacc[2];
  {
#pragma unroll
    for (int mt = 0; mt < 2; ++mt)
#pragma unroll
      for (int i = 0; i < 16; ++i) uacc[mt][i] = 0.f;
#pragma unroll
    for (int s = 0; s < 2; ++s) {
      const int j0 = r - 16 * s - 8 * hh;
      u32x4 iw;
      iw.x = (j0 == 0 ? 0x3F80u : 0u) | (j0 == 1 ? 0x3F800000u : 0u); iw.y = (j0 == 2 ? 0x3F80u : 0u) | (j0 == 3 ? 0x3F800000u : 0u);
      iw.z = (j0 == 4 ? 0x3F80u : 0u) | (j0 == 5 ? 0x3F800000u : 0u); iw.w = (j0 == 6 ? 0x3F80u : 0u) | (j0 == 7 ? 0x3F800000u : 0u);
      const bf16x8 ifr = __builtin_bit_cast(bf16x8, iw);
      const int chunkk = 2 * (2 * cg + s) + hh;
#pragma unroll
      for (int mt = 0; mt < 2; ++mt) { const int row = th * 64 + mt * 32 + r; const bf16x8 af = *(const bf16x8*)(sU + row * 256 + ((chunkk ^ (row & 15)) << 4)); uacc[mt] = MFMA32(af, ifr, uacc[mt]); }
    }
  }
  float hf[2][16];
#pragma unroll
  for (int dir = 0; dir < 2; ++dir) {
    __builtin_amdgcn_sched_barrier(0);
    if (dir == 1) ldw(1);
    f32x16 acc[2][2];
#pragma unroll
    for (int g = 0; g < 2; ++g)
#pragma unroll
      for (int mt = 0; mt < 2; ++mt)
#pragma unroll
        for (int i = 0; i < 16; ++i) acc[g][mt][i] = 0.f;
#pragma unroll
    for (int ks = 0; ks < 8; ++ks) { const int chunkk = 2 * ks + hh;
      bf16x8 af[2];
#pragma unroll
      for (int mt = 0; mt < 2; ++mt) { const int row = th * 64 + mt * 32 + r; af[mt] = *(const bf16x8*)(sU + row * 256 + ((chunkk ^ (row & 15)) << 4)); }
#pragma unroll
      for (int mt = 0; mt < 2; ++mt) { acc[0][mt] = MFMA32(af[mt], bw[0][ks], acc[0][mt]); acc[1][mt] = MFMA32(af[mt], bw[1][ks], acc[1][mt]); }
    }
    __builtin_amdgcn_sched_barrier(0);
    const float nbr = -1.4426950408889634f * p.b_rgate[dir * 1024 + ch], nbi = -1.4426950408889634f * p.b_igate[dir * 1024 + ch];
    const float c8 = -8.f * 1.4426950408889634f * softplusf(-p.lru_lambda[dir * 1024 + ch]);
#pragma unroll
    for (int mt = 0; mt < 2; ++mt)
#pragma unroll
      for (int reg = 0; reg < 16; ++reg) {
        const float rg = frcp(1.f + __builtin_amdgcn_exp2f(__builtin_fmaf(acc[0][mt][reg], -1.4426950408889634f, nbr)));
        const float ig = frcp(1.f + __builtin_amdgcn_exp2f(__builtin_fmaf(acc[1][mt][reg], -1.4426950408889634f, nbi)));
        const float a = __builtin_amdgcn_exp2f(c8 * rg);
        const float om = __builtin_fmaf(-a, a, 1.f);
        acc[0][mt][reg] = a; acc[1][mt][reg] = __builtin_amdgcn_sqrtf(om) * ig * uacc[mt][reg]; }
    __builtin_amdgcn_sched_barrier(0);
    float GA[8], GB[8], OA[8], OB[8];
#pragma unroll
    for (int mt = 0; mt < 2; ++mt)
#pragma unroll
      for (int g = 0; g < 4; ++g) { const int i = mt * 4 + g;
        const float a0 = acc[0][mt][4 * g], a1 = acc[0][mt][4 * g + 1], a2 = acc[0][mt][4 * g + 2], a3 = acc[0][mt][4 * g + 3];
        const float b0 = acc[1][mt][4 * g], b1 = acc[1][mt][4 * g + 1], b2 = acc[1][mt][4 * g + 2], b3 = acc[1][mt][4 * g + 3];
        GA[i] = (a0 * a1) * (a2 * a3);
        GB[i] = (dir == 0) ? ((b0 * a1 + b1) * a2 + b2) * a3 + b3 : ((b3 * a2 + b2) * a1 + b1) * a0 + b0;
        OA[i] = xother32(GA[i], hh); OB[i] = xother32(GB[i], hh); }
    const bool mefirst = (dir == 0) ? (hh == 0) : (hh == 1);
    float hcar = 0.f;
    if (PASS2) hcar = p.carry[((size_t)dir * 320 + chunk) * 1024 + ch];
    float cin_[8]; float ap = 1.f; float cur = hcar;
#pragma unroll
    for (int ii = 0; ii < 8; ++ii) { const int i = (dir == 0) ? ii : 7 - ii;
      const float fA = mefirst ? GA[i] : OA[i], fB = mefirst ? GB[i] : OB[i], sA_ = mefirst ? OA[i] : GA[i], sB_ = mefirst ? OB[i] : GB[i];
      cin_[i] = mefirst ? cur : (fA * cur + fB);
      cur = sA_ * (fA * cur + fB) + sB_; ap *= fA * sA_; }
    if (!PASS2) { if (hh == 0) { float* ag = p.agg + ((size_t)dir * 320 + chunk) * 2048 + ch; ag[0] = ap; ag[1024] = cur; } }
    else {
#pragma unroll
      for (int mt = 0; mt < 2; ++mt)
#pragma unroll
        for (int g = 0; g < 4; ++g) { const int i = mt * 4 + g; float hv = cin_[i];
          if (dir == 0) {
#pragma unroll
            for (int j = 0; j < 4; ++j) { hv = acc[0][mt][4 * g + j] * hv + acc[1][mt][4 * g + j]; hf[mt][4 * g + j] = hv; }
          } else {
#pragma unroll
            for (int j = 3; j >= 0; --j) { hv = acc[0][mt][4 * g + j] * hv + acc[1][mt][4 * g + j]; hf[mt][4 * g + j] += hv; }
            if (ctx && chunk == cfirst && mt == 0 && g == 0 && hh == 0) p.out[OUT_ST + (size_t)b * 2048 + 1024 + ch] = hv;
          }
        }
      if (dir == 0 && ctx && chunk == clast && hh == 1) p.out[OUT_ST + (size_t)b * 2048 + ch] = hf[1][15];
    }
  }
  if (PASS2) {
#pragma unroll
    for (int mt = 0; mt < 2; ++mt)
#pragma unroll
      for (int reg = 0; reg < 16; ++reg) sS[(th * 64 + mt * 32 + crow(reg, hh)) * 128 + chl] = hf[mt][reg];
    __syncthreads();
    const int cc = tid & 15, tg = tid >> 4;
#pragma unroll
    for (int t = 0; t < 4; ++t) { const int row = tg * 4 + t; const int tok = tok0 + row;
      const f32x4 s0 = *(const f32x4*)(sS + row * 128 + cc * 8), s1 = *(const f32x4*)(sS + row * 128 + cc * 8 + 4);
      const u32x4 gw = *(const u32x4*)(p.glru + (size_t)tok * 1024 + ch0 + cc * 8);
      u32x4 w;
      w.x = pack2(s0[0] * siluf(bflo(gw.x)), s0[1] * siluf(bfhi(gw.x))); w.y = pack2(s0[2] * siluf(bflo(gw.y)), s0[3] * siluf(bfhi(gw.y)));
      w.z = pack2(s1[0] * siluf(bflo(gw.z)), s1[1] * siluf(bfhi(gw.z))); w.w = pack2(s1[2] * siluf(bflo(gw.w)), s1[3] * siluf(bfhi(gw.w)));
      *(u32x4*)(p.glru + (size_t)tok * 1024 + ch0 + cc * 8) = w; }
  }
  __syncthreads();
}

DI void phase_carry(const Params& p, int wv) {
  TID_DECL
  const int g = blockIdx.x * NTHR + tid;
  if (g >= 40960) return;
  const int ch = g & 1023, sq = (g >> 10) % 20, dir = g / 20480;
  const bool ctx = sq < 16;
  const int cfirst = ctx ? sq * 4 : 64 + (sq - 16) * 64, n = ctx ? 4 : 64;
  float h = ctx ? 0.f : p.state_lru[(size_t)(sq - 16) * 2048 + dir * 1024 + ch];
  const float* ag = p.agg + (size_t)dir * 320 * 2048 + ch; float* cy = p.carry + (size_t)dir * 320 * 1024 + ch;
  if (dir == 0) {
#pragma unroll 8
    for (int j = 0; j < n; ++j) { const int c = cfirst + j; const float a = ag[(size_t)c * 2048], b = ag[(size_t)c * 2048 + 1024]; cy[(size_t)c * 1024] = h; h = a * h + b; }
  } else {
#pragma unroll 8
    for (int j = n - 1; j >= 0; --j) { const int c = cfirst + j; const float a = ag[(size_t)c * 2048], b = ag[(size_t)c * 2048 + 1024]; cy[(size_t)c * 1024] = h; h = a * h + b; }
  }
}

DI float lambda_full(const Params& p, int lane) {
  float a = p.lq1[lane] * p.lk1[lane], c = p.lq2[lane] * p.lk2[lane];
#pragma unroll
  for (int o = 32; o >= 1; o >>= 1) { a += __shfl_xor(a, o); c += __shfl_xor(c, o); }
  return __expf(a) - __expf(c) + 0.2f;
}
DI int kperm(int r) { return (r & ~12) | ((r & 4) << 1) | ((r & 8) >> 1); }

typedef unsigned u32x2v __attribute__((ext_vector_type(2)));
DI float xmax32(float x) { const u32x2v t = __builtin_amdgcn_permlane32_swap(__float_as_uint(x), __float_as_uint(x), false, false); return fmaxf(__uint_as_float(t.x), __uint_as_float(t.y)); }
DI float max3f(float a, float b, float c) { float r_; asm("v_max3_f32 %0, %1, %2, %3" : "=v"(r_) : "v"(a), "v"(b), "v"(c)); return r_; }
DI float xsum32(float x) { const u32x2v t = __builtin_amdgcn_permlane32_swap(__float_as_uint(x), __float_as_uint(x), false, false); return __uint_as_float(t.x) + __uint_as_float(t.y); }

DI void attn_item(const Params& p, bool ctx, int b, int hd, int qb, int wv) {
  TID_DECL const int r = lane & 31, hh = lane >> 5;
  const int rg = wave >> 1, m = wave & 1;
  const int Tk = ctx ? 256 : 4608;
  const bf16_t* Kb = (ctx ? p.Kc + (size_t)b * 256 * 1024 : p.Ks + (size_t)b * 4608 * 1024) + hd * 128;
  const bf16_t* Vb = ctx ? p.Vtc + (size_t)(b * 8 + hd) * 128 * 256 : p.Vts + (size_t)(b * 8 + hd) * 128 * 4608;
  const int tokq = (ctx ? b * 256 : NCTX + b * 4096) + qb * 128 + rg * 32 + r;
  bf16x8 qf[4];
#pragma unroll
  for (int ks = 0; ks < 4; ++ks) qf[ks] = *(const bf16x8*)(p.q + (size_t)tokq * 1024 + hd * 128 + m * 64 + ks * 16 + hh * 8);
  f32x16 O[4];
#pragma unroll
  for (int et = 0; et < 4; ++et)
#pragma unroll
    for (int i = 0; i < 16; ++i) O[et][i] = 0.f;
  float mrun, lsum = 0.f;
  const int krow0 = tid >> 4, kch = tid & 15;
  const int vrow0 = tid >> 3, vch = tid & 7;
  struct Stg { u32x4 k[2], v[2]; };
  auto ld_tile = [&](int kt, Stg& g) {
#pragma unroll
    for (int i = 0; i < 2; ++i) {
      g.k[i] = *(const u32x4*)(Kb + (size_t)(kt * 64 + krow0 + 32 * i) * 1024 + kch * 8);
      g.v[i] = *(const u32x4*)(Vb + (size_t)(vrow0 + 64 * i) * Tk + kt * 64 + vch * 8); }
  };
  auto st_tile = [&](char* buf, const Stg& g) {
#pragma unroll
    for (int i = 0; i < 2; ++i) { const int kr_ = krow0 + 32 * i; *(u32x4*)(buf + kr_ * 256 + ((kch ^ (kr_ & 15)) << 4)) = g.k[i];
      const int vr = vrow0 + 64 * i; *(u32x4*)(buf + 16384 + vr * 128 + ((vch ^ ((vr >> 1) & 7)) << 4)) = g.v[i]; }
  };
  const int kr = kperm(r);
#define SB_MEM ((void)0)
  auto compute_S = [&](const char* buf, f32x16 (&s)[2]) {
    bf16x8 kf[2][4];
#pragma unroll
    for (int sub = 0; sub < 2; ++sub) { const int krow = sub * 32 + kr;
#pragma unroll
      for (int ks = 0; ks < 4; ++ks) { const int chunk = m * 8 + 2 * ks + hh; kf[sub][ks] = *(const bf16x8*)(buf + krow * 256 + ((chunk ^ (krow & 15)) << 4)); } }
    SB_MEM;
#pragma unroll
    for (int sub = 0; sub < 2; ++sub)
#pragma unroll
      for (int i = 0; i < 16; ++i) s[sub][i] = 0.f;
#pragma unroll
    for (int ks = 0; ks < 4; ++ks)
#pragma unroll
      for (int sub = 0; sub < 2; ++sub) s[sub] = MFMA32(kf[sub][ks], qf[ks], s[sub]);
    SB_MEM;
  };
  auto rowmax = [&](const f32x16 (&s)[2]) {
    float mx = max3f(s[0][0], s[0][1], s[0][2]);
#pragma unroll
    for (int i = 3; i < 15; i += 2) mx = max3f(mx, s[0][i], s[0][i + 1]);
    mx = max3f(mx, s[0][15], s[1][0]);
#pragma unroll
    for (int i = 1; i < 15; i += 2) mx = max3f(mx, s[1][i], s[1][i + 1]);
    mx = fmaxf(mx, s[1][15]);
    return xmax32(mx);
  };
  auto softmax_pv = [&](const char* buf, const f32x16 (&s)[2]) {
    bf16x8 pf[4]; float ps = 0.f;
#pragma unroll
    for (int sub = 0; sub < 2; ++sub) { float pv[16];
#pragma unroll
      for (int i = 0; i < 16; ++i) { pv[i] = __builtin_amdgcn_exp2f(s[sub][i] - mrun); ps += pv[i]; }
#pragma unroll
      for (int s2 = 0; s2 < 2; ++s2) { u32x4 w; w.x = pack2(pv[8 * s2], pv[8 * s2 + 1]); w.y = pack2(pv[8 * s2 + 2], pv[8 * s2 + 3]); w.z = pack2(pv[8 * s2 + 4], pv[8 * s2 + 5]); w.w = pack2(pv[8 * s2 + 6], pv[8 * s2 + 7]);
        pf[sub * 2 + s2] = __builtin_bit_cast(bf16x8, w); }
    }
    lsum += ps;
    bf16x8 vf[2][4];
#pragma unroll
    for (int et = 0; et < 4; ++et) { const int vr = et * 32 + r; vf[0][et] = *(const bf16x8*)(buf + 16384 + vr * 128 + (((hh) ^ ((vr >> 1) & 7)) << 4)); }
    SB_MEM;
#pragma unroll
    for (int s4 = 0; s4 < 4; ++s4) {
      if (s4 < 3) {
#pragma unroll
        for (int et = 0; et < 4; ++et) { const int vr = et * 32 + r; const int chunk = 2 * (s4 + 1) + hh; vf[(s4 + 1) & 1][et] = *(const bf16x8*)(buf + 16384 + vr * 128 + ((chunk ^ ((vr >> 1) & 7)) << 4)); }
      }
      SB_MEM;
#pragma unroll
      for (int et = 0; et < 4; ++et) O[et] = MFMA32(vf[s4 & 1][et], pf[s4], O[et]);
      SB_MEM;
    }
  };
  const int nkt = Tk >> 6;
  if (wave >= 4) __builtin_amdgcn_s_setprio(1);
  Stg gA, gB;
  ld_tile(0, gA); ld_tile(1, gB); st_tile(lds, gA); st_tile(lds + 32768, gB);
  ld_tile(2, gA); ld_tile(3, gB);
  __syncthreads();
  f32x16 sc[2];
  compute_S(lds, sc);
  mrun = rowmax(sc);
  int o0 = 0, o1 = 32768, o2 = 65536;
  auto step = [&](int kt, Stg& g) {
    f32x16 sn[2];
    compute_S(lds + o1, sn);
    st_tile(lds + o2, g);
    { const int kt4 = (kt + 4 < nkt) ? kt + 4 : nkt - 1; ld_tile(kt4, g); }
    softmax_pv(lds + o0, sc);
    const float mx = rowmax(sn);
    if (__any(mx > mrun + 8.f)) {
      asm volatile("" ::: "memory");
      const float mn = fmaxf(mrun, mx); const float alpha = __builtin_amdgcn_exp2f(mrun - mn); mrun = mn; lsum *= alpha;
#pragma unroll
      for (int et = 0; et < 4; ++et)
#pragma unroll
        for (int i = 0; i < 16; ++i) O[et][i] *= alpha;
    }
#pragma unroll
    for (int sub = 0; sub < 2; ++sub) sc[sub] = sn[sub];
    __syncthreads();
    const int t = o0; o0 = o1; o1 = o2; o2 = t;
  };
  int kt = 0;
  for (; kt + 1 < nkt - 1; kt += 2) { step(kt, gA); step(kt + 1, gB); }
  if (kt < nkt - 1) step(kt, gA);
  softmax_pv(lds + o0, sc);
  if (wave >= 4) __builtin_amdgcn_s_setprio(0);
  __syncthreads();
  const float lam = lambda_full(p, lane);
  const float ltot = xsum32(lsum);
  float* ex = (float*)lds + rg * 4096;
  if (m == 1) { const float i2 = lam / ltot;
#pragma unroll
    for (int et = 0; et < 4; ++et)
#pragma unroll
      for (int i = 0; i < 16; ++i) ex[(et * 32 + crow(i, hh)) * 32 + r] = O[et][i] * i2; }
  __syncthreads();
  if (m == 0) {
    const float i1 = 1.f / ltot; float ss = 0.f;
#pragma unroll
    for (int et = 0; et < 4; ++et)
#pragma unroll
      for (int i = 0; i < 16; ++i) { const float o = O[et][i] * i1 - ex[(et * 32 + crow(i, hh)) * 32 + r]; O[et][i] = o; ss += o * o; }
    ss = xsum32(ss);
    const float rstd = rsqrtf(ss * (1.f / 128.f) + EPSF) * 0.8f;
#pragma unroll
    for (int et = 0; et < 4; ++et)
#pragma unroll
      for (int g = 0; g < 4; ++g) { const int e0 = et * 32 + 8 * g + 4 * hh;
        const f32x4 gs = *(const f32x4*)(p.g_subln + e0);
        const u32x2 ga = *(const u32x2*)(p.gatt + (size_t)tokq * 1024 + hd * 128 + e0);
        const float v0 = O[et][4 * g] * rstd * gs[0] * siluf(bflo(ga.x)), v1 = O[et][4 * g + 1] * rstd * gs[1] * siluf(bfhi(ga.x));
        const float v2 = O[et][4 * g + 2] * rstd * gs[2] * siluf(bflo(ga.y)), v3 = O[et][4 * g + 3] * rstd * gs[3] * siluf(bfhi(ga.y));
        u32x2 w; w.x = pack2(v0, v1); w.y = pack2(v2, v3);
        *(u32x2*)(p.gatt + (size_t)tokq * 1024 + hd * 128 + e0) = w; }
  }
  __syncthreads();
}

DI void phase4(const Params& p, int wv) {
  const int G = gridDim.x;
  const bool xmap = (G & 7) == 0 && (1024 % G) == 0 && (256 % G) == 0;
  for (int it = blockIdx.x; it < 1024; it += G) {
    int b, hd, qb;
    if (xmap) { const int j = blockIdx.x >> 3, i = it / G; const int idx = i * (G >> 3) + j; hd = blockIdx.x & 7; b = idx >> 5; qb = idx & 31; }
    else { b = it >> 8; hd = (it >> 5) & 7; qb = it & 31; }
    attn_item(p, false, b, hd, qb, wv);
  }
  for (int it = blockIdx.x; it < 256; it += G) {
    int b, hd, qb;
    if (xmap) { const int j = blockIdx.x >> 3, i = it / G; const int idx = i * (G >> 3) + j; hd = blockIdx.x & 7; b = idx >> 1; qb = idx & 1; }
    else { b = it >> 4; hd = (it >> 1) & 7; qb = it & 1; }
    attn_item(p, true, b, hd, qb, wv);
  }
  for (int u = blockIdx.x; u < 1280; u += G) lru_unit<true>(p, u, wv);
}

struct SchedOut {
  const bf16_t* att; const bf16_t* lru; const bf16_t* woutT; int G, c;
  DI bool next(int i, pg8::Unit& u) const {
    const int L = i * G + c; if (L >= 640) return false;
    const int kh = L / 320, t = L % 320; u.pm = t >> 2; u.pn = t & 3; u.type = kh;
    u.a = (const char*)((kh ? lru : att) + (size_t)u.pm * 256 * 1024); u.b = (const char*)(woutT + (size_t)kh * 1024 * 1024 + (size_t)u.pn * 256 * 1024);
    return true; }
  DI void a_ready(const pg8::Unit&) const {}
  DI void done(const pg8::Unit&) const {}
};
struct EpiOut {
  static constexpr bool PERM = true, AFTER_DRAIN = false;
  bf16_t* o2a; bf16_t* o2b;
  DI void operator()(const f32x4 (&acc)[2][2][4][2], const pg8::Unit& u, int wr, int wc, int fr, int fq) const {
#pragma unroll
    for (int ai = 0; ai < 2; ++ai)
#pragma unroll
      for (int m = 0; m < 4; ++m) { const int tok = u.pm * 256 + 128 * ai + 64 * wr + 16 * m + fr;
#pragma unroll
        for (int bj = 0; bj < 2; ++bj) { const int col = u.pn * 256 + 128 * bj + 32 * wc + 8 * fq;
          if (u.type) *(u32x4*)(o2b + (size_t)tok * 1024 + col) = pack8(acc[ai][bj][m][0], acc[ai][bj][m][1]);
          else *(u32x4*)(o2a + (size_t)tok * 1024 + col) = pack8(acc[ai][bj][m][0], acc[ai][bj][m][1]); } }
  }
};
DI void phase5(const Params& p, int wv) {
  TID_DECL
  SchedOut S{p.gatt, p.glru, p.woutT, (int)gridDim.x, (int)blockIdx.x};
  EpiOut E{(bf16_t*)p.o2b, (bf16_t*)p.o2b + (size_t)NTOK * 1024};
  pg8::gemm_phase<EpiOut, SchedOut, true, true>((PG8_LAS unsigned char*)lds, 1024, S, E, tid, wave);
}

DI void phase6(const Params& p, int wv) {
  TID_DECL
#pragma unroll 2
  for (int u = blockIdx.x; u < NTOK / NWAVE; u += gridDim.x) {
    const int tok = u * NWAVE + wave; const float* x = xrow(p, tok); const float* md = p.mod + modidx(tok) * 3072 + 2048; const bf16_t* o = (const bf16_t*)p.o2b + (size_t)tok * 1024; const bf16_t* ob = o + (size_t)NTOK * 1024;
    f32x4 ov[4]; float ss = 0.f;
#pragma unroll
    for (int i = 0; i < 4; ++i) { const u32x2 wa = *(const u32x2*)(o + lane * 4 + 256 * i), wb = *(const u32x2*)(ob + lane * 4 + 256 * i);
      ov[i] = (f32x4){bflo(wa.x) + bflo(wb.x), bfhi(wa.x) + bfhi(wb.x), bflo(wa.y) + bflo(wb.y), bfhi(wa.y) + bfhi(wb.y)}; ss += ov[i][0] * ov[i][0] + ov[i][1] * ov[i][1] + ov[i][2] * ov[i][2] + ov[i][3] * ov[i][3]; }
#pragma unroll
    for (int s = 32; s >= 1; s >>= 1) ss += __shfl_xor(ss, s);
    const float rstd = rsqrtf(ss * (1.f / 1024.f) + EPSF);
#pragma unroll
    for (int i = 0; i < 4; ++i) { const int col = lane * 4 + 256 * i;
      const f32x4 g = *(const f32x4*)(p.g_post + col), gt = *(const f32x4*)(md + col), xv = *(const f32x4*)(x + col);
      f32x4 y;
#pragma unroll
      for (int j = 0; j < 4; ++j) y[j] = xv[j] + gt[j] * (ov[i][j] * rstd * g[j]);
      *(f32x4*)(p.out + (size_t)tok * 1024 + col) = y; }
  }
}

#define XB_TMO      128
#define XB_XCNT(j)  (256  + 64 * (j))
#define XB_XSUB(j)  (1280 + 64 * (j))
#define XB_XGEN(j)  (2304 + 64 * (j))
#define XB_TOP      3328
#define XB_TOPGEN   3392
#define XCD_BAR_WORDS 3456
#define XB_SPIN_CAP (1u << 20)
DI unsigned xb_ld(unsigned* p) { return __hip_atomic_load(p, __ATOMIC_RELAXED, __HIP_MEMORY_SCOPE_AGENT); }
DI unsigned xb_add(unsigned* p, unsigned v) { return __hip_atomic_fetch_add(p, v, __ATOMIC_RELAXED, __HIP_MEMORY_SCOPE_AGENT); }
DI unsigned xb_xcc_id() { return (unsigned)__builtin_amdgcn_s_getreg((3 << 11) | 20) & 0xFu; }
#define XB_SPIN(cond, bar) do { unsigned _sp = 0; while (cond) { __builtin_amdgcn_s_sleep(1); \
    if ((++_sp & 255u) == 0u) { if (xb_ld(&(bar)[XB_TMO])) break; if (_sp > XB_SPIN_CAP) { atomicAdd(&(bar)[XB_TMO], 1u); break; } } } } while (0)
DI void xcd_barrier_complete(unsigned* bar, unsigned x, unsigned& nloc, unsigned& nx) {
  const unsigned G = gridDim.x;
  unsigned sum, cnt, mine, sp = 0u;
  for (;;) {
    sum = 0u; cnt = 0u; mine = 0u;
#pragma unroll
    for (unsigned j = 0; j < 16; ++j) { const unsigned c = xb_ld(&bar[XB_XCNT(j)]); sum += c; cnt += (c > 0u) ? 1u : 0u; mine = (j == x) ? c : mine; }
    if (sum == G) break;
    __builtin_amdgcn_s_sleep(1);
    if ((++sp & 255u) == 0u) { if (xb_ld(&bar[XB_TMO])) break; if (sp > XB_SPIN_CAP) { atomicAdd(&bar[XB_TMO], 1u); break; } }
  }
  nloc = mine > 0u ? mine : 1u; nx = cnt > 0u ? cnt : 1u;
}
DI void grid_barrier(unsigned* bar, bool leader) {
  asm volatile("s_waitcnt vmcnt(0)" ::: "memory");
  __syncthreads();
  if (leader) {
    volatile unsigned* st = (volatile unsigned*)(lds + 131072);
    const unsigned x = xb_xcc_id();
    __builtin_amdgcn_s_waitcnt(0);
    unsigned nloc = st[0], nx = st[1];
    if (nloc == 0u) { xcd_barrier_complete(bar, x, nloc, nx); st[0] = nloc; st[1] = nx; }
    const unsigned old = xb_add(&bar[XB_XSUB(x)], 1u);
    const unsigned gen = old / nloc;
    if (old + 1u == (gen + 1u) * nloc) {
      __builtin_amdgcn_fence(__ATOMIC_RELEASE, "agent");
      asm volatile("s_waitcnt vmcnt(0)" ::: "memory");
      const unsigned og = xb_add(&bar[XB_TOP], 1u);
      const unsigned tg = og / nx;
      if (og + 1u == (tg + 1u) * nx) xb_add(&bar[XB_TOPGEN], 1u);
      else XB_SPIN(xb_ld(&bar[XB_TOPGEN]) == tg, bar);
      __builtin_amdgcn_fence(__ATOMIC_ACQUIRE, "agent");
      xb_add(&bar[XB_XGEN(x)], 1u);
      asm volatile("s_waitcnt vmcnt(0)" ::: "memory");
    } else {
      XB_SPIN(xb_ld(&bar[XB_XGEN(x)]) == gen, bar);
      __builtin_amdgcn_fence(__ATOMIC_ACQUIRE, "agent");
      asm volatile("s_waitcnt vmcnt(0)" ::: "memory");
    }
  }
  __syncthreads();
}

__global__ void __launch_bounds__(512) fwd_megakernel(Params p) {
  const int lo = p.phase_lo, hi = p.phase_hi;
  const int wv = __builtin_amdgcn_readfirstlane((int)(threadIdx.x >> 6));
  const bool leader = (wv == 0) && (lane_id() == 0);
  if (hi - lo > 1) {
    if (leader) { *(uint4*)(lds + 131072) = make_uint4(0u, 0u, 0u, 0u); (void)xb_add(&p.bar[XB_XCNT(xb_xcc_id())], 1u); }
    __syncthreads();
  }
  if (lo <= 0 && hi > 0) phase0(p, wv);
  if (lo < 1 && hi > 1) grid_barrier(p.bar, leader);
  if (lo <= 1 && hi > 1) phase1(p, wv);
  if (lo < 2 && hi > 2) grid_barrier(p.bar, leader);
  if (lo <= 2 && hi > 2) phase2(p, wv);
  if (lo < 3 && hi > 3) grid_barrier(p.bar, leader);
  if (lo <= 3 && hi > 3) { for (int u = blockIdx.x; u < 1280; u += gridDim.x) lru_unit<false>(p, u, wv); }
  if (lo < 4 && hi > 4) grid_barrier(p.bar, leader);
  if (lo <= 4 && hi > 4) { phase_carry(p, wv); grid_barrier(p.bar, leader); phase4(p, wv); }
  if (lo < 5 && hi > 5) grid_barrier(p.bar, leader);
  if (lo <= 5 && hi > 5) phase5(p, wv);
  if (lo < 6 && hi > 6) grid_barrier(p.bar, leader);
  if (lo <= 6 && hi > 6) phase6(p, wv);
}

extern "C" void kernel_launch(void* const* d_in, const int* in_sizes, int n_in, void* d_out, int out_size, void* d_ws, size_t ws_size, hipStream_t stream) {
  static int grid_blocks = 0;
  if (!grid_blocks) {
    int dev = 0, cus = 0, per_cu = 0;
    (void)hipGetDevice(&dev);
    (void)hipDeviceGetAttribute(&cus, hipDeviceAttributeMultiprocessorCount, dev);
    (void)hipOccupancyMaxActiveBlocksPerMultiprocessor(&per_cu, fwd_megakernel, NTHR, 0);
    if (per_cu > 1) per_cu = 1;
    if (per_cu < 1) per_cu = 1;
    grid_blocks = cus * per_cu;
  }
  Params p{};
  const float** fp = (const float**)&p;
  for (int i = 0; i < 25; ++i) fp[i] = (const float*)d_in[i];
  p.out = (float*)d_out;
  char* w = (char*)d_ws; size_t off = 0;
  auto take = [&](size_t bytes) { char* r = w + off; off += (bytes + 255) & ~(size_t)255; return r; };
  p.mod = (float*)take(5 * 3072 * 4);
  p.winT = (bf16_t*)take((size_t)6144 * 1024 * 2);
  p.woutT = (bf16_t*)take((size_t)1024 * 2048 * 2);
  p.wgT = (bf16_t*)take((size_t)32 * 16384 * 2);
  p.h = (bf16_t*)d_out;
  p.q = p.h + (size_t)NTOK * 1024;
  p.Kc = (bf16_t*)take((size_t)4096 * 1024 * 2);
  p.Ks = (bf16_t*)take((size_t)4 * 4608 * 1024 * 2);
  p.Vtc = (bf16_t*)take((size_t)16 * 8 * 128 * 256 * 2);
  p.Vts = (bf16_t*)take((size_t)4 * 8 * 128 * 4608 * 2);
  p.gatt = (bf16_t*)take((size_t)NTOK * 1024 * 2);
  p.xlru = (bf16_t*)take((size_t)NTOK * 1024 * 2);
  p.glru = (bf16_t*)take((size_t)NTOK * 1024 * 2);
  p.agg = (float*)take((size_t)2 * 320 * 2048 * 4);
  p.carry = (float*)take((size_t)2 * 320 * 1024 * 4);
  p.o2 = (float*)d_out;
  p.o2b = (float*)p.Kc;
  p.bar = (unsigned*)take(XCD_BAR_WORDS * 4);
  if (off > ws_size) { fprintf(stderr, "workspace too small: need %zu have %zu\n", off, ws_size); return; }
#if MULTI_LAUNCH
  for (int ph = 0; ph < 7; ++ph) { p.phase_lo = ph; p.phase_hi = ph + 1; hipLaunchKernelGGL(fwd_megakernel, dim3(grid_blocks), dim3(NTHR), 0, stream, p); }
#else
  (void)hipMemsetAsync(p.bar, 0, XCD_BAR_WORDS * 4, stream);
  p.phase_lo = 0; p.phase_hi = 7;
  void* args[] = {&p};
  hipError_t e = hipLaunchCooperativeKernel((void*)fwd_megakernel, dim3(grid_blocks), dim3(NTHR), args, 0, stream);
  if (e != hipSuccess) fprintf(stderr, "cooperative launch failed: %s (grid %d)\n", hipGetErrorString(e), grid_blocks);
#endif
}
```

```cpp
#include <hip/hip_runtime.h>
#include <cstdio>
#include <cstdint>

#ifndef MULTI_LAUNCH
#define MULTI_LAUNCH 0
#endif

#define DI __device__ __forceinline__
typedef unsigned short bf16_t;
typedef short bf16x8 __attribute__((ext_vector_type(8)));
typedef float f32x16 __attribute__((ext_vector_type(16)));
typedef float f32x4 __attribute__((ext_vector_type(4)));
typedef float f32x2 __attribute__((ext_vector_type(2)));
typedef unsigned u32x4 __attribute__((ext_vector_type(4)));
typedef unsigned u32x2 __attribute__((ext_vector_type(2)));
typedef __bf16 bf16x2_t __attribute__((ext_vector_type(2)));
#define MFMA32(a, b, c) __builtin_amdgcn_mfma_f32_32x32x16_bf16((a), (b), (c), 0, 0, 0)

constexpr int NTOK = 20480, NCTX = 4096, NTHR = 512, NWAVE = 8;
constexpr float EPSF = 1e-6f;
constexpr int OUT_NK = 20971520, OUT_NV = 25165824, OUT_ST = 29360128;

struct Params {
  const float *x_prompt, *x_sample, *cache_k, *cache_v, *state_lru, *c, *c_ctx, *w_ada, *b_ada, *g_pre, *w_in;
  const float *lq1, *lk1, *lq2, *lk2, *g_subln, *conv_w, *conv_b, *w_rgate, *b_rgate, *w_igate, *b_igate, *lru_lambda, *w_out, *g_post;
  float* out;
  float* mod;
  bf16_t* winT;
  bf16_t* woutT;
  bf16_t* wgT;
  bf16_t* h;
  bf16_t* q;
  bf16_t* Kc;
  bf16_t* Ks;
  bf16_t* Vtc;
  bf16_t* Vts;
  bf16_t* gatt;
  bf16_t* xlru;
  bf16_t* glru;
  float* agg;
  float* carry;
  float* o2;
  float* o2b;
  unsigned* bar;
  int phase_lo, phase_hi;
};

DI int lane_id() { return (int)__builtin_amdgcn_mbcnt_hi(~0u, __builtin_amdgcn_mbcnt_lo(~0u, 0u)); }
#define TID_DECL int lane_v_ = lane_id(); asm volatile("" : "+v"(lane_v_)); const int lane = lane_v_; const int wave = wv; const int tid = wave * 64 + lane; (void)tid; (void)lane; (void)wave;
DI unsigned pack2(float lo, float hi) { f32x2 v = {lo, hi}; bf16x2_t b = __builtin_convertvector(v, bf16x2_t); return __builtin_bit_cast(unsigned, b); }
DI float bflo(unsigned u) { return __uint_as_float(u << 16); }
DI float bfhi(unsigned u) { return __uint_as_float(u & 0xffff0000u); }
DI float bf1(bf16_t h) { return __uint_as_float(((unsigned)h) << 16); }
DI bf16_t f2bf(float f) { return (bf16_t)(pack2(f, 0.f) & 0xffffu); }
DI float frcp(float x) { return __builtin_amdgcn_rcpf(x); }
DI float siluf(float x) { return x * frcp(1.f + __expf(-x)); }
DI float sigm(float x) { return frcp(1.f + __expf(-x)); }
DI int crow(int reg, int hh) { return (reg & 3) + 8 * (reg >> 2) + 4 * hh; }
typedef unsigned u32x2s __attribute__((ext_vector_type(2)));
DI float xother32(float x, int hh) { const u32x2s t = __builtin_amdgcn_permlane32_swap(__float_as_uint(x), __float_as_uint(x), false, false); return __uint_as_float(hh ? t.x : t.y); }
DI const float* xrow(const Params& p, int tok) { return tok < NCTX ? p.x_prompt + (size_t)tok * 1024 : p.x_sample + (size_t)(tok - NCTX) * 1024; }
DI int modidx(int tok) { return tok < NCTX ? 0 : 1 + ((tok - NCTX) >> 12); }

__shared__ __attribute__((aligned(16))) char lds[131072 + 16];

DI void transpose_tile(const float* src, size_t sld, bf16_t* dst, size_t dld, int r0, int c0, float* sm, int wv) {
  const int lx = lane_id(), ly = wv;
#pragma unroll
  for (int i = 0; i < 8; ++i) { const int r = ly + 8 * i; sm[r * 65 + lx] = src[(size_t)(r0 + r) * sld + c0 + lx]; }
  __syncthreads();
  const int rp = lx & 31, cs = lx >> 5;
#pragma unroll
  for (int i = 0; i < 4; ++i) { const int cc = cs + 2 * ly + 16 * i;
    *(unsigned*)(dst + (size_t)(c0 + cc) * dld + r0 + 2 * rp) = pack2(sm[(2 * rp) * 65 + cc], sm[(2 * rp + 1) * 65 + cc]); }
  __syncthreads();
}

DI void transpose_strip(const float* src, size_t sld, bf16_t* dst, size_t dld, int r0, int c0, float* sm, int wv) {
  const int lx = lane_id(), ly = wv;
  f32x4 v[8];
#pragma unroll
  for (int i = 0; i < 8; ++i) v[i] = __builtin_nontemporal_load((const f32x4*)(src + (size_t)(r0 + ly + 8 * i) * sld + c0 + 4 * lx));
#pragma unroll
  for (int i = 0; i < 8; ++i) { float* row = sm + (ly + 8 * i) * 257 + 4 * lx; row[0] = v[i][0]; row[1] = v[i][1]; row[2] = v[i][2]; row[3] = v[i][3]; }
  __syncthreads();
  const int tid = ly * 64 + lx, rp = tid & 31, cb = tid >> 5;
#pragma unroll
  for (int i = 0; i < 16; ++i) { const int cc = cb + 16 * i;
    *(unsigned*)(dst + (size_t)(c0 + cc) * dld + r0 + 2 * rp) = pack2(sm[(2 * rp) * 257 + cc], sm[(2 * rp + 1) * 257 + cc]); }
  __syncthreads();
}

DI void mod_unit(const Params& p, int u, int wv) {
  float* sc = (float*)lds;
  float* red = sc + 5120;
  TID_DECL
  for (int i = tid; i < 5120; i += NTHR) { const int mi = i >> 10, k = i & 1023; const float cv = (mi == 0) ? p.c_ctx[k] : p.c[(mi - 1) * 1024 + k]; sc[i] = siluf(cv); }
  __syncthreads();
  const int col = tid & 15, kg = tid >> 4, n = u * 16 + col;
  float a0 = 0.f, a1 = 0.f, a2 = 0.f, a3 = 0.f, a4 = 0.f;
#pragma unroll 16
  for (int k = kg * 32; k < kg * 32 + 32; ++k) {
    const float w = __builtin_nontemporal_load(p.w_ada + (size_t)k * 3072 + n);
    a0 += sc[k] * w; a1 += sc[1024 + k] * w; a2 += sc[2048 + k] * w; a3 += sc[3072 + k] * w; a4 += sc[4096 + k] * w;
  }
  red[(kg * 5 + 0) * 16 + col] = a0; red[(kg * 5 + 1) * 16 + col] = a1; red[(kg * 5 + 2) * 16 + col] = a2; red[(kg * 5 + 3) * 16 + col] = a3; red[(kg * 5 + 4) * 16 + col] = a4;
  __syncthreads();
  if (tid < 80) { const int mi = tid >> 4, cc = tid & 15; float s = p.b_ada[u * 16 + cc];
#pragma unroll
    for (int g = 0; g < 32; ++g) s += red[(g * 5 + mi) * 16 + cc];
    p.mod[mi * 3072 + u * 16 + cc] = s; }
  __syncthreads();
}

DI void phase0(const Params& p, int wv) {
  constexpr int NU_MOD = 192, NU_WIN = 384, NU_WOUT = 128, NU_G = 128, NU_CV = 128, NU_CK = 512;
  constexpr int TOTAL = NU_MOD + NU_WIN + NU_WOUT + NU_G + NU_CV + NU_CK;
  float* sm = (float*)lds;
  for (int u = blockIdx.x; u < TOTAL; u += gridDim.x) {
    int v = u;
    if (v < NU_MOD) { mod_unit(p, v, wv); continue; } v -= NU_MOD;
    if (v < NU_WIN) { const int tr = v / 24, tc = v % 24; transpose_strip(p.w_in, 6144, p.winT, 1024, tr * 64, tc * 256, sm, wv); continue; } v -= NU_WIN;
    if (v < NU_WOUT) { const int half = v >> 6, t = v & 63; const int tr = t >> 2, tc = t & 3;
      transpose_strip(p.w_out + (size_t)half * 1024 * 1024, 1024, p.woutT + (size_t)half * 1024 * 1024, 1024, tr * 64, tc * 256, sm, wv); continue; } v -= NU_WOUT;
    if (v < NU_G) { const int mtx = v >> 2, t = v & 3; const int dir = mtx >> 4, gate = (mtx >> 3) & 1, blk = mtx & 7;
      const float* src = (gate ? p.w_igate : p.w_rgate) + (size_t)(dir * 8 + blk) * 16384;
      transpose_tile(src, 128, p.wgT + (size_t)mtx * 16384, 128, (t >> 1) * 64, (t & 1) * 64, sm, wv); continue; } v -= NU_G;
    if (v < NU_CV) { const int b = v >> 5, t = v & 31; const int tr = t >> 2, tc = t & 3;
      transpose_strip(p.cache_v + (size_t)b * 512 * 1024, 1024, p.Vts + (size_t)b * 1024 * 4608, 4608, tr * 64, tc * 256, sm, wv); continue; } v -= NU_CV;
    { const size_t i0 = (size_t)v * 4096 + (wv * 64 + lane_id()) * 8; const size_t b = i0 / (512 * 1024), rem = i0 % (512 * 1024);
      const f32x4 x0 = __builtin_nontemporal_load((const f32x4*)(p.cache_k + i0)), x1 = __builtin_nontemporal_load((const f32x4*)(p.cache_k + i0 + 4));
      u32x4 w; w.x = pack2(x0[0], x0[1]); w.y = pack2(x0[2], x0[3]); w.z = pack2(x1[0], x1[1]); w.w = pack2(x1[2], x1[3]);
      *(u32x4*)(p.Ks + b * (size_t)4608 * 1024 + rem) = w; }
  }
}

DI void phase1(const Params& p, int wv) {
  TID_DECL
#pragma unroll 2
  for (int u = blockIdx.x; u < NTOK / NWAVE; u += gridDim.x) {
    const int tok = u * NWAVE + wave; const float* x = xrow(p, tok); const float* md = p.mod + modidx(tok) * 3072;
    f32x4 xv[4]; float ss = 0.f;
#pragma unroll
    for (int i = 0; i < 4; ++i) { xv[i] = __builtin_nontemporal_load((const f32x4*)(x + lane * 4 + 256 * i)); ss += xv[i][0] * xv[i][0] + xv[i][1] * xv[i][1] + xv[i][2] * xv[i][2] + xv[i][3] * xv[i][3]; }
#pragma unroll
    for (int o = 32; o >= 1; o >>= 1) ss += __shfl_xor(ss, o);
    const float rstd = rsqrtf(ss * (1.f / 1024.f) + EPSF);
#pragma unroll
    for (int i = 0; i < 4; ++i) { const int col = lane * 4 + 256 * i;
      const f32x4 g = *(const f32x4*)(p.g_pre + col), sh = *(const f32x4*)(md + col), scl = *(const f32x4*)(md + 1024 + col);
      float o[4];
#pragma unroll
      for (int j = 0; j < 4; ++j) o[j] = xv[i][j] * rstd * g[j] * (1.f + scl[j]) + sh[j];
      u32x2 w; w.x = pack2(o[0], o[1]); w.y = pack2(o[2], o[3]);
      *(u32x2*)(p.h + (size_t)tok * 1024 + col) = w; }
  }
}

#define LDS_AS(p) ((__attribute__((address_space(3))) unsigned*)(p))
template <int MT>
DI void g_issue(const bf16_t* A, int lda, const bf16_t* Bt, int ldb, int m0, int n0, int k0, char* stage, int tid) {
  const int row0 = tid >> 3, ch = (tid & 7) ^ ((tid >> 4) & 7);
  const unsigned offa = (unsigned)((row0 * lda + ch * 8) * 2), offb = (unsigned)((row0 * ldb + ch * 8) * 2);
  const char* Ab = (const char*)(A + (size_t)m0 * lda + (k0 & 1023));
  const char* Bb = (const char*)(Bt + (size_t)n0 * ldb + k0);
#pragma unroll
  for (int i = 0; i < MT; ++i) __builtin_amdgcn_global_load_lds((const unsigned*)(Ab + (size_t)i * 64 * lda * 2 + offa), LDS_AS(stage + tid * 16 + i * 8192), 16, 0, 0);
#pragma unroll
  for (int i = 0; i < 4; ++i) __builtin_amdgcn_global_load_lds((const unsigned*)(Bb + (size_t)i * 64 * ldb * 2 + offb), LDS_AS(stage + MT * 8192 + tid * 16 + i * 8192), 16, 0, 0);
}
template <int MT>
DI void g_compute(const char* buf, f32x16 (&acc)[MT][2], int wr, int wc, int lane) {
  const int r = lane & 31, hh = lane >> 5;
  bf16x8 af[2][MT], bg[2][2];
  auto rd = [&](int ks, int s) { const int chunk = 2 * ks + hh;
#pragma unroll
    for (int nt = 0; nt < 2; ++nt) { const int row = wc * 64 + nt * 32 + r; bg[s][nt] = *(const bf16x8*)(buf + MT * 8192 + row * 128 + ((chunk ^ ((row >> 1) & 7)) << 4)); }
#pragma unroll
    for (int mt = 0; mt < MT; ++mt) { const int row = wr * (32 * MT) + mt * 32 + r; af[s][mt] = *(const bf16x8*)(buf + row * 128 + ((chunk ^ ((row >> 1) & 7)) << 4)); } };
  rd(0, 0);
  __builtin_amdgcn_sched_barrier(0);
#pragma unroll
  for (int ks = 0; ks < 4; ++ks) {
    if (ks < 3) rd(ks + 1, (ks + 1) & 1);
    __builtin_amdgcn_sched_barrier(0);
#pragma unroll
    for (int mt = 0; mt < MT; ++mt)
#pragma unroll
      for (int nt = 0; nt < 2; ++nt) acc[mt][nt] = MFMA32(af[ks & 1][mt], bg[ks & 1][nt], acc[mt][nt]);
    __builtin_amdgcn_sched_barrier(0);
  }
}
template <int MT>
DI void gemm_tile(const bf16_t* A, const bf16_t* A2, int lda, const bf16_t* Bt, int ldb, int K, int m0, int n0, f32x16 (&acc)[MT][2], int wv) {
  TID_DECL const int wr = wave >> 2, wc = wave & 3;
  constexpr int STAGE = MT * 8192 + 32768;
  const int nk = K >> 6;
  g_issue<MT>(A, lda, Bt, ldb, m0, n0, 0, lds, tid);
#pragma unroll
  for (int mt = 0; mt < MT; ++mt)
#pragma unroll
    for (int nt = 0; nt < 2; ++nt)
#pragma unroll
      for (int i = 0; i < 16; ++i) acc[mt][nt][i] = 0.f;
  __syncthreads();
  for (int kt = 0; kt < nk; kt += 2) {
    g_issue<MT>((kt + 1) < 16 ? A : A2, lda, Bt, ldb, m0, n0, (kt + 1) << 6, lds + STAGE, tid);
    g_compute<MT>(lds, acc, wr, wc, lane);
    __syncthreads();
    if (kt + 2 < nk) g_issue<MT>((kt + 2) < 16 ? A : A2, lda, Bt, ldb, m0, n0, (kt + 2) << 6, lds, tid);
    g_compute<MT>(lds + STAGE, acc, wr, wc, lane);
    __syncthreads();
  }
}

namespace pg8 {
#define PG8_LAS __attribute__((address_space(3)))
constexpr int BM = 256, BK = 64, HALF = 128, HTB = HALF * BK * 2  , STAGE_BYTES = 8 * HTB, NXCD = 8, WGM = 8;

__host__ __device__ __forceinline__ int lds_byte(int r, int c) { const int st = (r >> 4) * 2 + (c >> 5), rr = r & 15, cc = c & 31, ob = rr * 64 + cc * 2; return st * 1024 + (ob ^ (((ob >> 9) & 1) << 5)); }
__host__ __device__ __forceinline__ void stage_rc(int b, int& R, int& C) { const int st = b / 1024, sb = b % 1024, swz = sb ^ (((sb >> 9) & 1) << 5); R = (st >> 1) * 16 + swz / 64; C = (st & 1) * 32 + (swz % 64) / 2; }
__host__ __device__ __forceinline__ int perm32(int rho) { const int n = rho >> 4, i = rho & 15; return 8 * (i >> 2) + 4 * n + (i & 3); }
struct Unit { int pm, pn, type; const char* a; const char* b; };
template <class Epi, class Sched, bool ALIGN_EPI = false, bool SP2 = false>
__device__ __forceinline__ void gemm_phase(PG8_LAS unsigned char* lds, const int K, const Sched& S, const Epi& E, const int tid_in, const int wid_in) {
    const int tid = tid_in, wid = wid_in, lane = tid & 63, wr = wid >> 2, wc = wid & 3, fr = lane & 15, fq = lane >> 4;
    const int nt = K / BK;
    unsigned voffA[2], voffB[2];
#pragma unroll
    for (int i = 0; i < 2; ++i) { int R, C; stage_rc(tid * 16 + i * 8192, R, C); const int Rb = Epi::PERM ? ((R & ~31) + perm32(R & 31)) : R;
        voffA[i] = (unsigned)(R * K + C) * 2u; voffB[i] = (unsigned)(Rb * K + C) * 2u; }
    const size_t kstep = (size_t)(BK * 2);
    const size_t hstep = (size_t)HALF * K * 2;
    const size_t tstep = 2 * hstep; (void)tstep;
    const unsigned ldsw = (unsigned)wid * 1024u;
    const int aoff = lds_byte(wr * 64 + fr, fq * 8), boff = lds_byte(wc * 32 + fr, fq * 8);
#define PG8_SA(b, h) (((b) * 2 + (h)) * HTB)
#define PG8_SB(b, h) ((4 + (b) * 2 + (h)) * HTB)
#define PG8_STAGE(bufoff, gbase, voff) do { _Pragma("unroll") for (int _i = 0; _i < 2; ++_i) \
        __builtin_amdgcn_global_load_lds((const unsigned*)((const char*)(gbase) + (voff)[_i]), (PG8_LAS unsigned*)(lds + (bufoff) + ldsw + _i * 8192), 16, 0, 0); } while (0)
#define PG8_LDA(dst, b, h) do { _Pragma("unroll") for (int m = 0; m < 4; ++m) _Pragma("unroll") for (int k = 0; k < 2; ++k) dst[m][k] = *(const PG8_LAS bf16x8*)(lds + PG8_SA(b, h) + aoff + m * 2048 + k * 1024); } while (0)
#define PG8_LDB(dst, b, h) do { _Pragma("unroll") for (int n = 0; n < 2; ++n) _Pragma("unroll") for (int k = 0; k < 2; ++k) dst[n][k] = *(const PG8_LAS bf16x8*)(lds + PG8_SB(b, h) + boff + n * 2048 + k * 1024); } while (0)
#define PG8_MMA(ai, bj, At, Bt) do { __builtin_amdgcn_s_setprio(1); _Pragma("unroll") for (int m = 0; m < 4; ++m) _Pragma("unroll") for (int n = 0; n < 2; ++n) _Pragma("unroll") for (int k = 0; k < 2; ++k) \
        acc[ai][bj][m][n] = __builtin_amdgcn_mfma_f32_16x16x32_bf16(Bt[n][k], At[m][k], acc[ai][bj][m][n], 0, 0, 0); __builtin_amdgcn_s_setprio(0); } while (0)
#define PG8_WAIT_V(n) asm volatile("s_waitcnt vmcnt(" #n ")" ::: "memory")
#define PG8_WAIT_L(n) asm volatile("s_waitcnt lgkmcnt(" #n ")" ::: "memory")
#define PG8_BAR __builtin_amdgcn_s_barrier()
#define PG8_SCHED __builtin_amdgcn_sched_barrier(0)
    Unit cur, nxt; int ui = 0;
    if (!S.next(0, cur)) return;
    f32x4 acc[2][2][4][2];
#pragma unroll
    for (int a = 0; a < 2; ++a)
#pragma unroll
        for (int b = 0; b < 2; ++b)
#pragma unroll
            for (int m = 0; m < 4; ++m)
#pragma unroll
                for (int n = 0; n < 2; ++n) acc[a][b][m][n] = (f32x4){0.f, 0.f, 0.f, 0.f};
    bf16x8 At[4][2], B0[2][2], B1[2][2];
    const char* cA = cur.a; const char* cB = cur.b;
    S.a_ready(cur);
    if constexpr (SP2) {
        PG8_STAGE(PG8_SB(0, 0), cB, voffB); PG8_STAGE(PG8_SB(0, 1), cB + hstep, voffB); PG8_STAGE(PG8_SA(0, 0), cA, voffA); PG8_STAGE(PG8_SA(0, 1), cA + hstep, voffA);
        if (wr == 1) PG8_BAR;
        PG8_WAIT_V(2); PG8_BAR;
        PG8_STAGE(PG8_SB(1, 0), cB + kstep, voffB); PG8_STAGE(PG8_SA(1, 0), cA + kstep, voffA); PG8_STAGE(PG8_SB(1, 1), cB + hstep + kstep, voffB);
        PG8_WAIT_V(6); PG8_BAR;
    } else {
        PG8_STAGE(PG8_SB(0, 0), cB, voffB); PG8_STAGE(PG8_SA(0, 0), cA, voffA); PG8_STAGE(PG8_SB(0, 1), cB + hstep, voffB); PG8_STAGE(PG8_SA(0, 1), cA + hstep, voffA);
        if (wr == 1) PG8_BAR;
        PG8_WAIT_V(4); PG8_BAR;
        PG8_STAGE(PG8_SB(1, 0), cB + kstep, voffB); PG8_STAGE(PG8_SA(1, 0), cA + kstep, voffA); PG8_STAGE(PG8_SB(1, 1), cB + hstep + kstep, voffB);
        PG8_WAIT_V(6); PG8_BAR;
    }
    for (;;) {
        const bool has_next = S.next(ui + 1, nxt);
        const char* nA = has_next ? nxt.a : cA; const char* nB = has_next ? nxt.b : cB;
        for (int t = 0; t < nt; t += 2) {
            const bool last = (t == nt - 2);
            const char* a1 = cA + (size_t)(t + 1) * kstep;
            const char* a2 = last ? nA : cA + (size_t)(t + 2) * kstep; const char* b2 = last ? nB : cB + (size_t)(t + 2) * kstep;
            const char* a3 = a2 + kstep; const char* b3 = b2 + kstep;
            if (last && has_next) S.a_ready(nxt);
            if constexpr (SP2) {
            PG8_LDB(B0, 0, 0); PG8_LDB(B1, 0, 1); PG8_SCHED; PG8_LDA(At, 0, 0); PG8_STAGE(PG8_SA(1, 1), a1 + hstep, voffA);
            PG8_WAIT_V(8); PG8_WAIT_L(0); PG8_BAR; PG8_MMA(0, 0, At, B0); PG8_MMA(0, 1, At, B1); PG8_BAR; PG8_SCHED;
            PG8_LDA(At, 0, 1); PG8_STAGE(PG8_SB(0, 0), b2, voffB); PG8_STAGE(PG8_SB(0, 1), b2 + hstep, voffB); PG8_STAGE(PG8_SA(0, 0), a2, voffA);
            PG8_WAIT_V(8); PG8_WAIT_L(0); PG8_BAR; PG8_MMA(1, 0, At, B0); PG8_MMA(1, 1, At, B1); PG8_BAR; PG8_SCHED;
            PG8_LDB(B0, 1, 0); PG8_LDB(B1, 1, 1); PG8_SCHED; PG8_LDA(At, 1, 0); PG8_STAGE(PG8_SA(0, 1), a2 + hstep, voffA);
            PG8_WAIT_V(8); PG8_WAIT_L(0); PG8_BAR; PG8_MMA(0, 0, At, B0); PG8_MMA(0, 1, At, B1); PG8_BAR; PG8_SCHED;
            PG8_LDA(At, 1, 1); PG8_STAGE(PG8_SB(1, 0), b3, voffB); PG8_STAGE(PG8_SB(1, 1), b3 + hstep, voffB); PG8_STAGE(PG8_SA(1, 0), a3, voffA);
            PG8_WAIT_V(8); PG8_WAIT_L(0); PG8_BAR; PG8_MMA(1, 0, At, B0); PG8_MMA(1, 1, At, B1); PG8_BAR; PG8_SCHED;
            } else {
            PG8_LDB(B0, 0, 0); PG8_SCHED; PG8_LDA(At, 0, 0); PG8_STAGE(PG8_SA(1, 1), a1 + hstep, voffA);
            PG8_WAIT_L(8); PG8_BAR; PG8_WAIT_L(0); PG8_MMA(0, 0, At, B0); PG8_BAR; PG8_SCHED;
            PG8_LDB(B1, 0, 1); PG8_STAGE(PG8_SB(0, 0), b2, voffB);
            PG8_BAR; PG8_WAIT_L(0); PG8_MMA(0, 1, At, B1); PG8_BAR;
            PG8_LDA(At, 0, 1); PG8_STAGE(PG8_SA(0, 0), a2, voffA);
            PG8_BAR; PG8_WAIT_L(0); PG8_MMA(1, 0, At, B0); PG8_BAR; PG8_SCHED;
            PG8_STAGE(PG8_SB(0, 1), b2 + hstep, voffB);
            PG8_WAIT_V(6); PG8_BAR; PG8_MMA(1, 1, At, B1); PG8_BAR;
            PG8_LDB(B0, 1, 0); PG8_SCHED; PG8_LDA(At, 1, 0); PG8_STAGE(PG8_SA(0, 1), a2 + hstep, voffA);
            PG8_WAIT_L(8); PG8_BAR; PG8_WAIT_L(0); PG8_MMA(0, 0, At, B0); PG8_BAR; PG8_SCHED;
            PG8_LDB(B1, 1, 1); PG8_STAGE(PG8_SB(1, 0), b3, voffB);
            PG8_BAR; PG8_WAIT_L(0); PG8_MMA(0, 1, At, B1); PG8_BAR;
            PG8_LDA(At, 1, 1); PG8_STAGE(PG8_SA(1, 0), a3, voffA);
            PG8_BAR; PG8_WAIT_L(0); PG8_MMA(1, 0, At, B0); PG8_BAR; PG8_SCHED;
            PG8_STAGE(PG8_SB(1, 1), b3 + hstep, voffB);
            PG8_WAIT_V(6); PG8_BAR; PG8_MMA(1, 1, At, B1); PG8_BAR;
            }
        }
        if constexpr (ALIGN_EPI) { if (wr == 0) PG8_BAR; }
        if constexpr (!Epi::AFTER_DRAIN) { E(acc, cur, wr, wc, fr, fq); S.done(cur); }
        if (!has_next) break;
#pragma unroll
        for (int a = 0; a < 2; ++a)
#pragma unroll
            for (int b = 0; b < 2; ++b)
#pragma unroll
                for (int m = 0; m < 4; ++m)
#pragma unroll
                    for (int n = 0; n < 2; ++n) acc[a][b][m][n] = (f32x4){0.f, 0.f, 0.f, 0.f};
        cur = nxt; cA = nA; cB = nB; ++ui;
        if constexpr (ALIGN_EPI) { if (wr == 1) PG8_BAR; }
    }
    PG8_WAIT_V(0);
    if constexpr (!ALIGN_EPI) { if (wr == 0) PG8_BAR; }
    PG8_BAR;
    if constexpr (Epi::AFTER_DRAIN) { E.fused(acc, cur, wr, wc, fr, fq, lds, wid, lane); S.done(cur); }
#undef PG8_SA
#undef PG8_SB
#undef PG8_STAGE
#undef PG8_LDA
#undef PG8_LDB
#undef PG8_MMA
#undef PG8_WAIT_V
#undef PG8_WAIT_L
#undef PG8_BAR
#undef PG8_SCHED
}
}

struct SchedIn {
  const bf16_t* h; const bf16_t* winT; int G, c;
  DI bool next(int i, pg8::Unit& u) const {
    const int L = i * G + c; if (L >= 1920) return false;
    if (L < 1600) {
      const int wg = (G == 256) ? (L & 7) * 200 + (L >> 3) : L; const int tm = (wg / 160) * 8 + (wg % 160) % 8, tn = (wg % 160) / 8; u.pm = tm; u.pn = tn < 8 ? tn : tn + 4; u.type = 0; u.a = (const char*)(h + (size_t)tm * 256 * 1024); u.b = (const char*)(winT + (size_t)u.pn * 256 * 1024); }
    else { const int v = L - 1600; u.pm = v & 3; u.pn = v >> 2; u.type = 1; u.a = (const char*)(winT + (size_t)(2048 + u.pm * 256) * 1024); u.b = (const char*)(h + (size_t)u.pn * 256 * 1024); }
    return true; }
  DI void a_ready(const pg8::Unit&) const {}
  DI void done(const pg8::Unit&) const {}
};
DI u32x4 pack8(const f32x4& a, const f32x4& b) { u32x4 w; w.x = pack2(a[0], a[1]); w.y = pack2(a[2], a[3]); w.z = pack2(b[0], b[1]); w.w = pack2(b[2], b[3]); return w; }
struct EpiIn {
  static constexpr bool PERM = true, AFTER_DRAIN = false;
  struct { bf16_t *q, *Kc, *Ks, *Vtc, *Vts, *gatt, *xlru, *glru; float* out; } p;
  DI void operator()(const f32x4 (&acc)[2][2][4][2], const pg8::Unit& u, int wr, int wc, int fr, int fq) const {
    if (u.type == 0) {
      const int m0 = u.pm * 256, n0 = u.pn * 256;
      const int ctype = n0 >> 10; const bool ctx = m0 < NCTX; const bool rope = (ctype <= 1) && !ctx;
      const int b = ctx ? (m0 >> 8) : ((m0 - NCTX) >> 12);
      const int hh = fq >> 1;
      float inv[2][4];
#pragma unroll
      for (int n = 0; n < 2; ++n)
#pragma unroll
        for (int j = 0; j < 4; ++j) inv[n][j] = __builtin_amdgcn_exp2f(-(float)(8 * (fq & 1) + 4 * n + j) * 0.8304820237218405f);
#pragma unroll
      for (int ai = 0; ai < 2; ++ai)
#pragma unroll
        for (int m = 0; m < 4; ++m) {
          __builtin_amdgcn_sched_barrier(0);
          const int tok = m0 + 128 * ai + 64 * wr + 16 * m + fr;
          const int t = ctx ? (tok & 255) : ((tok - NCTX) & 4095);
          float sn[2][4], cs[2][4];
          if (rope) { const float pos = (wc & 1) ? (float)(t & 63) : (float)(t >> 6);
#pragma unroll
            for (int n = 0; n < 2; ++n)
#pragma unroll
              for (int j = 0; j < 4; ++j) { const float ang = pos * inv[n][j]; sn[n][j] = __sinf(ang); cs[n][j] = __cosf(ang); } }
#pragma unroll
          for (int bj = 0; bj < 2; ++bj) {
            f32x4 v[2] = {acc[ai][bj][m][0], acc[ai][bj][m][1]};
            const int col = (n0 & 1023) + 128 * bj + 32 * wc + 8 * fq;
            if (rope) {
#pragma unroll
              for (int n = 0; n < 2; ++n)
#pragma unroll
                for (int j = 0; j < 4; ++j) { const float x = v[n][j]; const float xp = xother32(x, hh); v[n][j] = hh ? (xp * sn[n][j] + x * cs[n][j]) : (x * cs[n][j] - xp * sn[n][j]); }
            }
            if (ctype == 0) { v[0] = v[0] * 0.18033688011112042f; v[1] = v[1] * 0.18033688011112042f; *(u32x4*)(p.q + (size_t)tok * 1024 + col) = pack8(v[0], v[1]); }
            else if (ctype == 1) {
              if (ctx) { *(u32x4*)(p.Kc + (size_t)tok * 1024 + col) = pack8(v[0], v[1]); *(f32x4*)(p.out + OUT_NK + (size_t)tok * 1024 + col) = v[0]; *(f32x4*)(p.out + OUT_NK + (size_t)tok * 1024 + col + 4) = v[1]; }
              else *(u32x4*)(p.Ks + ((size_t)b * 4608 + 512 + t) * 1024 + col) = pack8(v[0], v[1]);
            } else if (ctype == 3) *(u32x4*)(p.gatt + (size_t)tok * 1024 + col) = pack8(v[0], v[1]);
            else if (ctype == 4) *(u32x4*)(p.xlru + (size_t)tok * 1024 + col) = pack8(v[0], v[1]);
            else if (ctype == 5) *(u32x4*)(p.glru + (size_t)tok * 1024 + col) = pack8(v[0], v[1]);
          }
        }
    } else {
      const int e0 = u.pm * 256, tk0 = u.pn * 256; const bool ctx = tk0 < NCTX;
      const int b = ctx ? (tk0 >> 8) : ((tk0 - NCTX) >> 12);
#pragma unroll
      for (int ai = 0; ai < 2; ++ai)
#pragma unroll
        for (int m = 0; m < 4; ++m) { const int erow = e0 + 128 * ai + 64 * wr + 16 * m + fr; const int hd = erow >> 7, ee = erow & 127;
#pragma unroll
          for (int bj = 0; bj < 2; ++bj) { const int tok = tk0 + 128 * bj + 32 * wc + 8 * fq; const int t = ctx ? (tok & 255) : ((tok - NCTX) & 4095);
            bf16_t* vt = ctx ? p.Vtc + ((size_t)(b * 8 + hd) * 128 + ee) * 256 + t : p.Vts + ((size_t)(b * 8 + hd) * 128 + ee) * 4608 + 512 + t;
            *(u32x4*)vt = pack8(acc[ai][bj][m][0], acc[ai][bj][m][1]);
            if (ctx) {
#pragma unroll
              for (int n = 0; n < 2; ++n)
#pragma unroll
                for (int j = 0; j < 4; ++j) p.out[OUT_NV + (size_t)(tok + 4 * n + j) * 1024 + erow] = acc[ai][bj][m][n][j];
            }
          } }
    }
  }
};
DI void phase2(const Params& p, int wv) {
  TID_DECL
  SchedIn S{p.h, p.winT, (int)gridDim.x, (int)blockIdx.x};
  EpiIn E{{p.q, p.Kc, p.Ks, p.Vtc, p.Vts, p.gatt, p.xlru, p.glru, p.out}};
  pg8::gemm_phase<EpiIn, SchedIn, true, true>((PG8_LAS unsigned char*)lds, 1024, S, E, tid, wave);
}

DI float softplusf(float x) { return x > 20.f ? x : log1pf(__expf(x)); }
template <bool PASS2>
DI void lru_unit(const Params& p, int unit, int wv) {
  TID_DECL const int r = lane & 31, hh = lane >> 5;
  const int c2 = unit >> 3, blk = unit & 7; const int tok0 = c2 * 128, ch0 = blk * 128;
  const bool ctx = tok0 < NCTX;
  const int seq_start = ctx ? (tok0 & ~255) : (NCTX + ((tok0 - NCTX) & ~4095)); const int seq_len = ctx ? 256 : 4096;
  const int b = ctx ? (tok0 >> 8) : ((tok0 - NCTX) >> 12);
  char* sU = lds;
  float* sS = (float*)(lds + 32768);
  const int cg_ = wave & 3; const int chl_ = cg_ * 32 + r;
  bf16x8 bw[2][8];
  auto ldw = [&](int dir) {
#pragma unroll
    for (int g = 0; g < 2; ++g) { const bf16_t* wp = p.wgT + ((size_t)((dir * 2 + g) * 8 + blk) * 128 + chl_) * 128;
#pragma unroll
      for (int ks = 0; ks < 8; ++ks) bw[g][ks] = *(const bf16x8*)(wp + (2 * ks + hh) * 8); }
  };
  ldw(0);
  { const int cc = tid & 15, tg = tid >> 4; const int c8 = ch0 + cc * 8;
    float xin[7][8];
#pragma unroll
    for (int j = 0; j < 7; ++j) { const int tok = tok0 + tg * 4 - 1 + j; const bool ok = tok >= seq_start && tok < seq_start + seq_len;
      u32x4 w = {0u, 0u, 0u, 0u}; if (ok) w = *(const u32x4*)(p.xlru + (size_t)tok * 1024 + c8);
      xin[j][0] = bflo(w.x); xin[j][1] = bfhi(w.x); xin[j][2] = bflo(w.y); xin[j][3] = bfhi(w.y); xin[j][4] = bflo(w.z); xin[j][5] = bfhi(w.z); xin[j][6] = bflo(w.w); xin[j][7] = bfhi(w.w); }
    float cw[4][8], cb[8];
#pragma unroll
    for (int j = 0; j < 4; ++j) { const f32x4 w0 = *(const f32x4*)(p.conv_w + j * 1024 + c8), w1 = *(const f32x4*)(p.conv_w + j * 1024 + c8 + 4);
      cw[j][0] = w0[0]; cw[j][1] = w0[1]; cw[j][2] = w0[2]; cw[j][3] = w0[3]; cw[j][4] = w1[0]; cw[j][5] = w1[1]; cw[j][6] = w1[2]; cw[j][7] = w1[3]; }
    { const f32x4 b0 = *(const f32x4*)(p.conv_b + c8), b1 = *(const f32x4*)(p.conv_b + c8 + 4); cb[0] = b0[0]; cb[1] = b0[1]; cb[2] = b0[2]; cb[3] = b0[3]; cb[4] = b1[0]; cb[5] = b1[1]; cb[6] = b1[2]; cb[7] = b1[3]; }
#pragma unroll
    for (int t = 0; t < 4; ++t) { float uu[8];
#pragma unroll
      for (int e = 0; e < 8; ++e) uu[e] = cb[e] + cw[0][e] * xin[t][e] + cw[1][e] * xin[t + 1][e] + cw[2][e] * xin[t + 2][e] + cw[3][e] * xin[t + 3][e];
      u32x4 w; w.x = pack2(uu[0], uu[1]); w.y = pack2(uu[2], uu[3]); w.z = pack2(uu[4], uu[5]); w.w = pack2(uu[6], uu[7]);
      const int row = tg * 4 + t; *(u32x4*)(sU + row * 256 + ((cc ^ (row & 15)) << 4)) = w; }
  }
  __syncthreads();
  const int cg = wave & 3, th = wave >> 2;
  const int chl = cg * 32 + r, ch = ch0 + chl;
  const int chunk = c2 * 2 + th;
  const int cfirst = seq_start >> 6, clast = (seq_start + seq_len - 64) >> 6;
  f32x16 uacc[2];
  {
#pragma unroll
    for (int mt = 0; mt < 2; ++mt)
#pragma unroll
      for (int i = 0; i < 16; ++i) uacc[mt][i] = 0.f;
#pragma unroll
    for (int s = 0; s < 2; ++s) {
      const int j0 = r - 16 * s - 8 * hh;
      u32x4 iw;
      iw.x = (j0 == 0 ? 0x3F80u : 0u) | (j0 == 1 ? 0x3F800000u : 0u); iw.y = (j0 == 2 ? 0x3F80u : 0u) | (j0 == 3 ? 0x3F800000u : 0u);
      iw.z = (j0 == 4 ? 0x3F80u : 0u) | (j0 == 5 ? 0x3F800000u : 0u); iw.w = (j0 == 6 ? 0x3F80u : 0u) | (j0 == 7 ? 0x3F800000u : 0u);
      const bf16x8 ifr = __builtin_bit_cast(bf16x8, iw);
      const int chunkk = 2 * (2 * cg + s) + hh;
#pragma unroll
      for (int mt = 0; mt < 2; ++mt) { const int row = th * 64 + mt * 32 + r; const bf16x8 af = *(const bf16x8*)(sU + row * 256 + ((chunkk ^ (row & 15)) << 4)); uacc[mt] = MFMA32(af, ifr, uacc[mt]); }
    }
  }
  float hf[2][16];
#pragma unroll
  for (int dir = 0; dir < 2; ++dir) {
    __builtin_amdgcn_sched_barrier(0);
    if (dir == 1) ldw(1);
    f32x16 acc[2][2];
#pragma unroll
    for (int g = 0; g < 2; ++g)
#pragma unroll
      for (int mt = 0; mt < 2; ++mt)
#pragma unroll
        for (int i = 0; i < 16; ++i) acc[g][mt][i] = 0.f;
#pragma unroll
    for (int ks = 0; ks < 8; ++ks) { const int chunkk = 2 * ks + hh;
      bf16x8 af[2];
#pragma unroll
      for (int mt = 0; mt < 2; ++mt) { const int row = th * 64 + mt * 32 + r; af[mt] = *(const bf16x8*)(sU + row * 256 + ((chunkk ^ (row & 15)) << 4)); }
#pragma unroll
      for (int mt = 0; mt < 2; ++mt) { acc[0][mt] = MFMA32(af[mt], bw[0][ks], acc[0][mt]); acc[1][mt] = MFMA32(af[mt], bw[1][ks], acc[1][mt]); }
    }
    __builtin_amdgcn_sched_barrier(0);
    const float nbr = -1.4426950408889634f * p.b_rgate[dir * 1024 + ch], nbi = -1.4426950408889634f * p.b_igate[dir * 1024 + ch];
    const float c8 = -8.f * 1.4426950408889634f * softplusf(-p.lru_lambda[dir * 1024 + ch]);
#pragma unroll
    for (int mt = 0; mt < 2; ++mt)
#pragma unroll
      for (int reg = 0; reg < 16; ++reg) {
        const float rg = frcp(1.f + __builtin_amdgcn_exp2f(__builtin_fmaf(acc[0][mt][reg], -1.4426950408889634f, nbr)));
        const float ig = frcp(1.f + __builtin_amdgcn_exp2f(__builtin_fmaf(acc[1][mt][reg], -1.4426950408889634f, nbi)));
        const float a = __builtin_amdgcn_exp2f(c8 * rg);
        const float om = __builtin_fmaf(-a, a, 1.f);
        acc[0][mt][reg] = a; acc[1][mt][reg] = __builtin_amdgcn_sqrtf(om) * ig * uacc[mt][reg]; }
    __builtin_amdgcn_sched_barrier(0);
    float GA[8], GB[8], OA[8], OB[8];
#pragma unroll
    for (int mt = 0; mt < 2; ++mt)
#pragma unroll
      for (int g = 0; g < 4; ++g) { const int i = mt * 4 + g;
        const float a0 = acc[0][mt][4 * g], a1 = acc[0][mt][4 * g + 1], a2 = acc[0][mt][4 * g + 2], a3 = acc[0][mt][4 * g + 3];
        const float b0 = acc[1][mt][4 * g], b1 = acc[1][mt][4 * g + 1], b2 = acc[1][mt][4 * g + 2], b3 = acc[1][mt][4 * g + 3];
        GA[i] = (a0 * a1) * (a2 * a3);
        GB[i] = (dir == 0) ? ((b0 * a1 + b1) * a2 + b2) * a3 + b3 : ((b3 * a2 + b2) * a1 + b1) * a0 + b0;
        OA[i] = xother32(GA[i], hh); OB[i] = xother32(GB[i], hh); }
    const bool mefirst = (dir == 0) ? (hh == 0) : (hh == 1);
    float hcar = 0.f;
    if (PASS2) hcar = p.carry[((size_t)dir * 320 + chunk) * 1024 + ch];
    float cin_[8]; float ap = 1.f; float cur = hcar;
#pragma unroll
    for (int ii = 0; ii < 8; ++ii) { const int i = (dir == 0) ? ii : 7 - ii;
      const float fA = mefirst ? GA[i] : OA[i], fB = mefirst ? GB[i] : OB[i], sA_ = mefirst ? OA[i] : GA[i], sB_ = mefirst ? OB[i] : GB[i];
      cin_[i] = mefirst ? cur : (fA * cur + fB);
      cur = sA_ * (fA * cur + fB) + sB_; ap *= fA * sA_; }
    if (!PASS2) { if (hh == 0) { float* ag = p.agg + ((size_t)dir * 320 + chunk) * 2048 + ch; ag[0] = ap; ag[1024] = cur; } }
    else {
#pragma unroll
      for (int mt = 0; mt < 2; ++mt)
#pragma unroll
        for (int g = 0; g < 4; ++g) { const int i = mt * 4 + g; float hv = cin_[i];
          if (dir == 0) {
#pragma unroll
            for (int j = 0; j < 4; ++j) { hv = acc[0][mt][4 * g + j] * hv + acc[1][mt][4 * g + j]; hf[mt][4 * g + j] = hv; }
          } else {
#pragma unroll
            for (int j = 3; j >= 0; --j) { hv = acc[0][mt][4 * g + j] * hv + acc[1][mt][4 * g + j]; hf[mt][4 * g + j] += hv; }
            if (ctx && chunk == cfirst && mt == 0 && g == 0 && hh == 0) p.out[OUT_ST + (size_t)b * 2048 + 1024 + ch] = hv;
          }
        }
      if (dir == 0 && ctx && chunk == clast && hh == 1) p.out[OUT_ST + (size_t)b * 2048 + ch] = hf[1][15];
    }
  }
  if (PASS2) {
#pragma unroll
    for (int mt = 0; mt < 2; ++mt)
#pragma unroll
      for (int reg = 0; reg < 16; ++reg) sS[(th * 64 + mt * 32 + crow(reg, hh)) * 128 + chl] = hf[mt][reg];
    __syncthreads();
    const int cc = tid & 15, tg = tid >> 4;
#pragma unroll
    for (int t = 0; t < 4; ++t) { const int row = tg * 4 + t; const int tok = tok0 + row;
      const f32x4 s0 = *(const f32x4*)(sS + row * 128 + cc * 8), s1 = *(const f32x4*)(sS + row * 128 + cc * 8 + 4);
      const u32x4 gw = *(const u32x4*)(p.glru + (size_t)tok * 1024 + ch0 + cc * 8);
      u32x4 w;
      w.x = pack2(s0[0] * siluf(bflo(gw.x)), s0[1] * siluf(bfhi(gw.x))); w.y = pack2(s0[2] * siluf(bflo(gw.y)), s0[3] * siluf(bfhi(gw.y)));
      w.z = pack2(s1[0] * siluf(bflo(gw.z)), s1[1] * siluf(bfhi(gw.z))); w.w = pack2(s1[2] * siluf(bflo(gw.w)), s1[3] * siluf(bfhi(gw.w)));
      *(u32x4*)(p.glru + (size_t)tok * 1024 + ch0 + cc * 8) = w; }
  }
  __syncthreads();
}

DI void phase_carry(const Params& p, int wv) {
  TID_DECL
  const int g = blockIdx.x * NTHR + tid;
  if (g >= 40960) return;
  const int ch = g & 1023, sq = (g >> 10) % 20, dir = g / 20480;
  const bool ctx = sq < 16;
  const int cfirst = ctx ? sq * 4 : 64 + (sq - 16) * 64, n = ctx ? 4 : 64;
  float h = ctx ? 0.f : p.state_lru[(size_t)(sq - 16) * 2048 + dir * 1024 + ch];
  const float* ag = p.agg + (size_t)dir * 320 * 2048 + ch; float* cy = p.carry + (size_t)dir * 320 * 1024 + ch;
  if (dir == 0) {
#pragma unroll 8
    for (int j = 0; j < n; ++j) { const int c = cfirst + j; const float a = ag[(size_t)c * 2048], b = ag[(size_t)c * 2048 + 1024]; cy[(size_t)c * 1024] = h; h = a * h + b; }
  } else {
#pragma unroll 8
    for (int j = n - 1; j >= 0; --j) { const int c = cfirst + j; const float a = ag[(size_t)c * 2048], b = ag[(size_t)c * 2048 + 1024]; cy[(size_t)c * 1024] = h; h = a * h + b; }
  }
}

DI float lambda_full(const Params& p, int lane) {
  float a = p.lq1[lane] * p.lk1[lane], c = p.lq2[lane] * p.lk2[lane];
#pragma unroll
  for (int o = 32; o >= 1; o >>= 1) { a += __shfl_xor(a, o); c += __shfl_xor(c, o); }
  return __expf(a) - __expf(c) + 0.2f;
}
DI int kperm(int r) { return (r & ~12) | ((r & 4) << 1) | ((r & 8) >> 1); }

typedef unsigned u32x2v __attribute__((ext_vector_type(2)));
DI float xmax32(float x) { const u32x2v t = __builtin_amdgcn_permlane32_swap(__float_as_uint(x), __float_as_uint(x), false, false); return fmaxf(__uint_as_float(t.x), __uint_as_float(t.y)); }
DI float max3f(float a, float b, float c) { float r_; asm("v_max3_f32 %0, %1, %2, %3" : "=v"(r_) : "v"(a), "v"(b), "v"(c)); return r_; }
DI float xsum32(float x) { const u32x2v t = __builtin_amdgcn_permlane32_swap(__float_as_uint(x), __float_as_uint(x), false, false); return __uint_as_float(t.x) + __uint_as_float(t.y); }

DI void attn_item(const Params& p, bool ctx, int b, int hd, int qb, int wv) {
  TID_DECL const int r = lane & 31, hh = lane >> 5;
  const int rg = wave >> 1, m = wave & 1;
  const int Tk = ctx ? 256 : 4608;
  const bf16_t* Kb = (ctx ? p.Kc + (size_t)b * 256 * 1024 : p.Ks + (size_t)b * 4608 * 1024) + hd * 128;
  const bf16_t* Vb = ctx ? p.Vtc + (size_t)(b * 8 + hd) * 128 * 256 : p.Vts + (size_t)(b * 8 + hd) * 128 * 4608;
  const int tokq = (ctx ? b * 256 : NCTX + b * 4096) + qb * 128 + rg * 32 + r;
  bf16x8 qf[4];
#pragma unroll
  for (int ks = 0; ks < 4; ++ks) qf[ks] = *(const bf16x8*)(p.q + (size_t)tokq * 1024 + hd * 128 + m * 64 + ks * 16 + hh * 8);
  f32x16 O[4];
#pragma unroll
  for (int et = 0; et < 4; ++et)
#pragma unroll
    for (int i = 0; i < 16; ++i) O[et][i] = 0.f;
  float mrun, lsum = 0.f;
  const int krow0 = tid >> 4, kch = tid & 15;
  const int vrow0 = tid >> 3, vch = tid & 7;
  struct Stg { u32x4 k[2], v[2]; };
  auto ld_tile = [&](int kt, Stg& g) {
#pragma unroll
    for (int i = 0; i < 2; ++i) {
      g.k[i] = *(const u32x4*)(Kb + (size_t)(kt * 64 + krow0 + 32 * i) * 1024 + kch * 8);
      g.v[i] = *(const u32x4*)(Vb + (size_t)(vrow0 + 64 * i) * Tk + kt * 64 + vch * 8); }
  };
  auto st_tile = [&](char* buf, const Stg& g) {
#pragma unroll
    for (int i = 0; i < 2; ++i) { const int kr_ = krow0 + 32 * i; *(u32x4*)(buf + kr_ * 256 + ((kch ^ (kr_ & 15)) << 4)) = g.k[i];
      const int vr = vrow0 + 64 * i; *(u32x4*)(buf + 16384 + vr * 128 + ((vch ^ ((vr >> 1) & 7)) << 4)) = g.v[i]; }
  };
  const int kr = kperm(r);
#define SB_MEM ((void)0)
  auto compute_S = [&](const char* buf, f32x16 (&s)[2]) {
    bf16x8 kf[2][4];
#pragma unroll
    for (int sub = 0; sub < 2; ++sub) { const int krow = sub * 32 + kr;
#pragma unroll
      for (int ks = 0; ks < 4; ++ks) { const int chunk = m * 8 + 2 * ks + hh; kf[sub][ks] = *(const bf16x8*)(buf + krow * 256 + ((chunk ^ (krow & 15)) << 4)); } }
    SB_MEM;
#pragma unroll
    for (int sub = 0; sub < 2; ++sub)
#pragma unroll
      for (int i = 0; i < 16; ++i) s[sub][i] = 0.f;
#pragma unroll
    for (int ks = 0; ks < 4; ++ks)
#pragma unroll
      for (int sub = 0; sub < 2; ++sub) s[sub] = MFMA32(kf[sub][ks], qf[ks], s[sub]);
    SB_MEM;
  };
  auto rowmax = [&](const f32x16 (&s)[2]) {
    float mx = max3f(s[0][0], s[0][1], s[0][2]);
#pragma unroll
    for (int i = 3; i < 15; i += 2) mx = max3f(mx, s[0][i], s[0][i + 1]);
    mx = max3f(mx, s[0][15], s[1][0]);
#pragma unroll
    for (int i = 1; i < 15; i += 2) mx = max3f(mx, s[1][i], s[1][i + 1]);
    mx = fmaxf(mx, s[1][15]);
    return xmax32(mx);
  };
  auto softmax_pv = [&](const char* buf, const f32x16 (&s)[2]) {
    bf16x8 pf[4]; float ps = 0.f;
#pragma unroll
    for (int sub = 0; sub < 2; ++sub) { float pv[16];
#pragma unroll
      for (int i = 0; i < 16; ++i) { pv[i] = __builtin_amdgcn_exp2f(s[sub][i] - mrun); ps += pv[i]; }
#pragma unroll
      for (int s2 = 0; s2 < 2; ++s2) { u32x4 w; w.x = pack2(pv[8 * s2], pv[8 * s2 + 1]); w.y = pack2(pv[8 * s2 + 2], pv[8 * s2 + 3]); w.z = pack2(pv[8 * s2 + 4], pv[8 * s2 + 5]); w.w = pack2(pv[8 * s2 + 6], pv[8 * s2 + 7]);
        pf[sub * 2 + s2] = __builtin_bit_cast(bf16x8, w); }
    }
    lsum += ps;
    bf16x8 vf[2][4];
#pragma unroll
    for (int et = 0; et < 4; ++et) { const int vr = et * 32 + r; vf[0][et] = *(const bf16x8*)(buf + 16384 + vr * 128 + (((hh) ^ ((vr >> 1) & 7)) << 4)); }
    SB_MEM;
#pragma unroll
    for (int s4 = 0; s4 < 4; ++s4) {
      if (s4 < 3) {
#pragma unroll
        for (int et = 0; et < 4; ++et) { const int vr = et * 32 + r; const int chunk = 2 * (s4 + 1) + hh; vf[(s4 + 1) & 1][et] = *(const bf16x8*)(buf + 16384 + vr * 128 + ((chunk ^ ((vr >> 1) & 7)) << 4)); }
      }
      SB_MEM;
#pragma unroll
      for (int et = 0; et < 4; ++et) O[et] = MFMA32(vf[s4 & 1][et], pf[s4], O[et]);
      SB_MEM;
    }
  };
  const int nkt = Tk >> 6;
  if (wave >= 4) __builtin_amdgcn_s_setprio(1);
  Stg gA, gB;
  ld_tile(0, gA); ld_tile(1, gB); st_tile(lds, gA); st_tile(lds + 32768, gB);
  ld_tile(2, gA); ld_tile(3, gB);
  __syncthreads();
  f32x16 sc[2];
  compute_S(lds, sc);
  mrun = rowmax(sc);
  int o0 = 0, o1 = 32768, o2 = 65536;
  auto step = [&](int kt, Stg& g) {
    f32x16 sn[2];
    compute_S(lds + o1, sn);
    st_tile(lds + o2, g);
    { const int kt4 = (kt + 4 < nkt) ? kt + 4 : nkt - 1; ld_tile(kt4, g); }
    softmax_pv(lds + o0, sc);
    const float mx = rowmax(sn);
    if (__any(mx > mrun + 8.f)) {
      asm volatile("" ::: "memory");
      const float mn = fmaxf(mrun, mx); const float alpha = __builtin_amdgcn_exp2f(mrun - mn); mrun = mn; lsum *= alpha;
#pragma unroll
      for (int et = 0; et < 4; ++et)
#pragma unroll
        for (int i = 0; i < 16; ++i) O[et][i] *= alpha;
    }
#pragma unroll
    for (int sub = 0; sub < 2; ++sub) sc[sub] = sn[sub];
    __syncthreads();
    const int t = o0; o0 = o1; o1 = o2; o2 = t;
  };
  int kt = 0;
  for (; kt + 1 < nkt - 1; kt += 2) { step(kt, gA); step(kt + 1, gB); }
  if (kt < nkt - 1) step(kt, gA);
  softmax_pv(lds + o0, sc);
  if (wave >= 4) __builtin_amdgcn_s_setprio(0);
  __syncthreads();
  const float lam = lambda_full(p, lane);
  const float ltot = xsum32(lsum);
  float* ex = (float*)lds + rg * 4096;
  if (m == 1) { const float i2 = lam / ltot;
#pragma unroll
    for (int et = 0; et < 4; ++et)
#pragma unroll
      for (int i = 0; i < 16; ++i) ex[(et * 32 + crow(i, hh)) * 32 + r] = O[et][i] * i2; }
  __syncthreads();
  if (m == 0) {
    const float i1 = 1.f / ltot; float ss = 0.f;
#pragma unroll
    for (int et = 0; et < 4; ++et)
#pragma unroll
      for (int i = 0; i < 16; ++i) { const float o = O[et][i] * i1 - ex[(et * 32 + crow(i, hh)) * 32 + r]; O[et][i] = o; ss += o * o; }
    ss = xsum32(ss);
    const float rstd = rsqrtf(ss * (1.f / 128.f) + EPSF) * 0.8f;
#pragma unroll
    for (int et = 0; et < 4; ++et)
#pragma unroll
      for (int g = 0; g < 4; ++g) { const int e0 = et * 32 + 8 * g + 4 * hh;
        const f32x4 gs = *(const f32x4*)(p.g_subln + e0);
        const u32x2 ga = *(const u32x2*)(p.gatt + (size_t)tokq * 1024 + hd * 128 + e0);
        const float v0 = O[et][4 * g] * rstd * gs[0] * siluf(bflo(ga.x)), v1 = O[et][4 * g + 1] * rstd * gs[1] * siluf(bfhi(ga.x));
        const float v2 = O[et][4 * g + 2] * rstd * gs[2] * siluf(bflo(ga.y)), v3 = O[et][4 * g + 3] * rstd * gs[3] * siluf(bfhi(ga.y));
        u32x2 w; w.x = pack2(v0, v1); w.y = pack2(v2, v3);
        *(u32x2*)(p.gatt + (size_t)tokq * 1024 + hd * 128 + e0) = w; }
  }
  __syncthreads();
}

DI void phase4(const Params& p, int wv) {
  const int G = gridDim.x;
  const bool xmap = (G & 7) == 0 && (1024 % G) == 0 && (256 % G) == 0;
  for (int it = blockIdx.x; it < 1024; it += G) {
    int b, hd, qb;
    if (xmap) { const int j = blockIdx.x >> 3, i = it / G; const int idx = i * (G >> 3) + j; hd = blockIdx.x & 7; b = idx >> 5; qb = idx & 31; }
    else { b = it >> 8; hd = (it >> 5) & 7; qb = it & 31; }
    attn_item(p, false, b, hd, qb, wv);
  }
  for (int it = blockIdx.x; it < 256; it += G) {
    int b, hd, qb;
    if (xmap) { const int j = blockIdx.x >> 3, i = it / G; const int idx = i * (G >> 3) + j; hd = blockIdx.x & 7; b = idx >> 1; qb = idx & 1; }
    else { b = it >> 4; hd = (it >> 1) & 7; qb = it & 1; }
    attn_item(p, true, b, hd, qb, wv);
  }
  for (int u = blockIdx.x; u < 1280; u += G) lru_unit<true>(p, u, wv);
}

struct SchedOut {
  const bf16_t* att; const bf16_t* lru; const bf16_t* woutT; int G, c;
  DI bool next(int i, pg8::Unit& u) const {
    const int L = i * G + c; if (L >= 640) return false;
    const int kh = L / 320, t = L % 320; u.pm = t >> 2; u.pn = t & 3; u.type = kh;
    u.a = (const char*)((kh ? lru : att) + (size_t)u.pm * 256 * 1024); u.b = (const char*)(woutT + (size_t)kh * 1024 * 1024 + (size_t)u.pn * 256 * 1024);
    return true; }
  DI void a_ready(const pg8::Unit&) const {}
  DI void done(const pg8::Unit&) const {}
};
struct EpiOut {
  static constexpr bool PERM = true, AFTER_DRAIN = false;
  bf16_t* o2a; bf16_t* o2b;
  DI void operator()(const f32x4 (&acc)[2][2][4][2], const pg8::Unit& u, int wr, int wc, int fr, int fq) const {
#pragma unroll
    for (int ai = 0; ai < 2; ++ai)
#pragma unroll
      for (int m = 0; m < 4; ++m) { const int tok = u.pm * 256 + 128 * ai + 64 * wr + 16 * m + fr;
#pragma unroll
        for (int bj = 0; bj < 2; ++bj) { const int col = u.pn * 256 + 128 * bj + 32 * wc + 8 * fq;
          if (u.type) *(u32x4*)(o2b + (size_t)tok * 1024 + col) = pack8(acc[ai][bj][m][0], acc[ai][bj][m][1]);
          else *(u32x4*)(o2a + (size_t)tok * 1024 + col) = pack8(acc[ai][bj][m][0], acc[ai][bj][m][1]); } }
  }
};
DI void phase5(const Params& p, int wv) {
  TID_DECL
  SchedOut S{p.gatt, p.glru, p.woutT, (int)gridDim.x, (int)blockIdx.x};
  EpiOut E{(bf16_t*)p.o2b, (bf16_t*)p.o2b + (size_t)NTOK * 1024};
  pg8::gemm_phase<EpiOut, SchedOut, true, true>((PG8_LAS unsigned char*)lds, 1024, S, E, tid, wave);
}

DI void phase6(const Params& p, int wv) {
  TID_DECL
#pragma unroll 2
  for (int u = blockIdx.x; u < NTOK / NWAVE; u += gridDim.x) {
    const int tok = u * NWAVE + wave; const float* x = xrow(p, tok); const float* md = p.mod + modidx(tok) * 3072 + 2048; const bf16_t* o = (const bf16_t*)p.o2b + (size_t)tok * 1024; const bf16_t* ob = o + (size_t)NTOK * 1024;
    f32x4 ov[4]; float ss = 0.f;
#pragma unroll
    for (int i = 0; i < 4; ++i) { const u32x2 wa = *(const u32x2*)(o + lane * 4 + 256 * i), wb = *(const u32x2*)(ob + lane * 4 + 256 * i);
      ov[i] = (f32x4){bflo(wa.x) + bflo(wb.x), bfhi(wa.x) + bfhi(wb.x), bflo(wa.y) + bflo(wb.y), bfhi(wa.y) + bfhi(wb.y)}; ss += ov[i][0] * ov[i][0] + ov[i][1] * ov[i][1] + ov[i][2] * ov[i][2] + ov[i][3] * ov[i][3]; }
#pragma unroll
    for (int s = 32; s >= 1; s >>= 1) ss += __shfl_xor(ss, s);
    const float rstd = rsqrtf(ss * (1.f / 1024.f) + EPSF);
#pragma unroll
    for (int i = 0; i < 4; ++i) { const int col = lane * 4 + 256 * i;
      const f32x4 g = *(const f32x4*)(p.g_post + col), gt = *(const f32x4*)(md + col), xv = __builtin_nontemporal_load((const f32x4*)(x + col));
      f32x4 y;
#pragma unroll
      for (int j = 0; j < 4; ++j) y[j] = xv[j] + gt[j] * (ov[i][j] * rstd * g[j]);
      *(f32x4*)(p.out + (size_t)tok * 1024 + col) = y; }
  }
}

#define XB_TMO      128
#define XB_XCNT(j)  (256  + 64 * (j))
#define XB_XSUB(j)  (1280 + 64 * (j))
#define XB_XGEN(j)  (2304 + 64 * (j))
#define XB_TOP      3328
#define XB_TOPGEN   3392
#define XCD_BAR_WORDS 3456
#define XB_SPIN_CAP (1u << 20)
DI unsigned xb_ld(unsigned* p) { return __hip_atomic_load(p, __ATOMIC_RELAXED, __HIP_MEMORY_SCOPE_AGENT); }
DI unsigned xb_add(unsigned* p, unsigned v) { return __hip_atomic_fetch_add(p, v, __ATOMIC_RELAXED, __HIP_MEMORY_SCOPE_AGENT); }
DI unsigned xb_xcc_id() { return (unsigned)__builtin_amdgcn_s_getreg((3 << 11) | 20) & 0xFu; }
#define XB_SPIN(cond, bar) do { unsigned _sp = 0; while (cond) { __builtin_amdgcn_s_sleep(1); \
    if ((++_sp & 255u) == 0u) { if (xb_ld(&(bar)[XB_TMO])) break; if (_sp > XB_SPIN_CAP) { atomicAdd(&(bar)[XB_TMO], 1u); break; } } } } while (0)
DI void xcd_barrier_complete(unsigned* bar, unsigned x, unsigned& nloc, unsigned& nx) {
  const unsigned G = gridDim.x;
  unsigned sum, cnt, mine, sp = 0u;
  for (;;) {
    sum = 0u; cnt = 0u; mine = 0u;
#pragma unroll
    for (unsigned j = 0; j < 16; ++j) { const unsigned c = xb_ld(&bar[XB_XCNT(j)]); sum += c; cnt += (c > 0u) ? 1u : 0u; mine = (j == x) ? c : mine; }
    if (sum == G) break;
    __builtin_amdgcn_s_sleep(1);
    if ((++sp & 255u) == 0u) { if (xb_ld(&bar[XB_TMO])) break; if (sp > XB_SPIN_CAP) { atomicAdd(&bar[XB_TMO], 1u); break; } }
  }
  nloc = mine > 0u ? mine : 1u; nx = cnt > 0u ? cnt : 1u;
}
DI void grid_barrier(unsigned* bar, bool leader) {
  asm volatile("s_waitcnt vmcnt(0)" ::: "memory");
  __syncthreads();
  if (leader) {
    volatile unsigned* st = (volatile unsigned*)(lds + 131072);
    const unsigned x = xb_xcc_id();
    __builtin_amdgcn_s_waitcnt(0);
    unsigned nloc = st[0], nx = st[1];
    if (nloc == 0u) { xcd_barrier_complete(bar, x, nloc, nx); st[0] = nloc; st[1] = nx; }
    const unsigned old = xb_add(&bar[XB_XSUB(x)], 1u);
    const unsigned gen = old / nloc;
    if (old + 1u == (gen + 1u) * nloc) {
      __builtin_amdgcn_fence(__ATOMIC_RELEASE, "agent");
      asm volatile("s_waitcnt vmcnt(0)" ::: "memory");
      const unsigned og = xb_add(&bar[XB_TOP], 1u);
      const unsigned tg = og / nx;
      if (og + 1u == (tg + 1u) * nx) xb_add(&bar[XB_TOPGEN], 1u);
      else XB_SPIN(xb_ld(&bar[XB_TOPGEN]) == tg, bar);
      __builtin_amdgcn_fence(__ATOMIC_ACQUIRE, "agent");
      xb_add(&bar[XB_XGEN(x)], 1u);
      asm volatile("s_waitcnt vmcnt(0)" ::: "memory");
    } else {
      XB_SPIN(xb_ld(&bar[XB_XGEN(x)]) == gen, bar);
      __builtin_amdgcn_fence(__ATOMIC_ACQUIRE, "agent");
      asm volatile("s_waitcnt vmcnt(0)" ::: "memory");
    }
  }
  __syncthreads();
}

__global__ void __launch_bounds__(512) fwd_megakernel(Params p) {
  const int lo = p.phase_lo, hi = p.phase_hi;
  const int wv = __builtin_amdgcn_readfirstlane((int)(threadIdx.x >> 6));
  const bool leader = (wv == 0) && (lane_id() == 0);
  if (hi - lo > 1) {
    if (leader) { *(uint4*)(lds + 131072) = make_uint4(0u, 0u, 0u, 0u); (void)xb_add(&p.bar[XB_XCNT(xb_xcc_id())], 1u); }
    __syncthreads();
  }
  if (lo <= 0 && hi > 0) phase0(p, wv);
  if (lo < 1 && hi > 1) grid_barrier(p.bar, leader);
  if (lo <= 1 && hi > 1) phase1(p, wv);
  if (lo < 2 && hi > 2) grid_barrier(p.bar, leader);
  if (lo <= 2 && hi > 2) phase2(p, wv);
  if (lo < 3 && hi > 3) grid_barrier(p.bar, leader);
  if (lo <= 3 && hi > 3) { for (int u = blockIdx.x; u < 1280; u += gridDim.x) lru_unit<false>(p, u, wv); }
  if (lo < 4 && hi > 4) grid_barrier(p.bar, leader);
  if (lo <= 4 && hi > 4) { phase_carry(p, wv); grid_barrier(p.bar, leader); phase4(p, wv); }
  if (lo < 5 && hi > 5) grid_barrier(p.bar, leader);
  if (lo <= 5 && hi > 5) phase5(p, wv);
  if (lo < 6 && hi > 6) grid_barrier(p.bar, leader);
  if (lo <= 6 && hi > 6) phase6(p, wv);
}

extern "C" void kernel_launch(void* const* d_in, const int* in_sizes, int n_in, void* d_out, int out_size, void* d_ws, size_t ws_size, hipStream_t stream) {
  static int grid_blocks = 0;
  if (!grid_blocks) {
    int dev = 0, cus = 0, per_cu = 0;
    (void)hipGetDevice(&dev);
    (void)hipDeviceGetAttribute(&cus, hipDeviceAttributeMultiprocessorCount, dev);
    (void)hipOccupancyMaxActiveBlocksPerMultiprocessor(&per_cu, fwd_megakernel, NTHR, 0);
    if (per_cu > 1) per_cu = 1;
    if (per_cu < 1) per_cu = 1;
    grid_blocks = cus * per_cu;
  }
  Params p{};
  const float** fp = (const float**)&p;
  for (int i = 0; i < 25; ++i) fp[i] = (const float*)d_in[i];
  p.out = (float*)d_out;
  char* w = (char*)d_ws; size_t off = 0;
  auto take = [&](size_t bytes) { char* r = w + off; off += (bytes + 255) & ~(size_t)255; return r; };
  p.mod = (float*)take(5 * 3072 * 4);
  p.winT = (bf16_t*)take((size_t)6144 * 1024 * 2);
  p.woutT = (bf16_t*)take((size_t)1024 * 2048 * 2);
  p.wgT = (bf16_t*)take((size_t)32 * 16384 * 2);
  p.h = (bf16_t*)d_out;
  p.q = p.h + (size_t)NTOK * 1024;
  p.Kc = (bf16_t*)take((size_t)4096 * 1024 * 2);
  p.Ks = (bf16_t*)take((size_t)4 * 4608 * 1024 * 2);
  p.Vtc = (bf16_t*)take((size_t)16 * 8 * 128 * 256 * 2);
  p.Vts = (bf16_t*)take((size_t)4 * 8 * 128 * 4608 * 2);
  p.gatt = (bf16_t*)take((size_t)NTOK * 1024 * 2);
  p.xlru = (bf16_t*)take((size_t)NTOK * 1024 * 2);
  p.glru = (bf16_t*)take((size_t)NTOK * 1024 * 2);
  p.agg = (float*)take((size_t)2 * 320 * 2048 * 4);
  p.carry = (float*)take((size_t)2 * 320 * 1024 * 4);
  p.o2 = (float*)d_out;
  p.o2b = (float*)p.Kc;
  p.bar = (unsigned*)take(XCD_BAR_WORDS * 4);
  if (off > ws_size) { fprintf(stderr, "workspace too small: need %zu have %zu\n", off, ws_size); return; }
#if MULTI_LAUNCH
  for (int ph = 0; ph < 7; ++ph) { p.phase_lo = ph; p.phase_hi = ph + 1; hipLaunchKernelGGL(fwd_megakernel, dim3(grid_blocks), dim3(NTHR), 0, stream, p); }
#else
  (void)hipMemsetAsync(p.bar, 0, XCD_BAR_WORDS * 4, stream);
  p.phase_lo = 0; p.phase_hi = 7;
  void* args[] = {&p};
  hipError_t e = hipLaunchCooperativeKernel((void*)fwd_megakernel, dim3(grid_blocks), dim3(NTHR), args, 0, stream);
  if (e != hipSuccess) fprintf(stderr, "cooperative launch failed: %s (grid %d)\n", hipGetErrorString(e), grid_blocks);
#endif
}
```
